# Optimizing an MI355X kernel written in HIP

```python
import math
import jax, jax.numpy as jnp
from jax import lax
import numpy as np

D_MODEL = 1024
BATCH = 16
SEQ = 2048
DEPTH = 2

EPS = 1e-6
PLE_DIM = 256
D_FF = 2816
CONV_W = 4
HEAD_DIM = 64
LRU_WIDTH = D_MODEL // 4
LRU_BLOCKS = LRU_WIDTH // HEAD_DIM
LRU_BLOCK = LRU_WIDTH // LRU_BLOCKS
LRU_C = 8.0
ATT_WIDTH = D_MODEL // 2
ATT_HEADS = ATT_WIDTH // HEAD_DIM
ATT_KV_HEADS = 2
ATT_GROUP = ATT_HEADS // ATT_KV_HEADS
KV_WIDTH = ATT_KV_HEADS * HEAD_DIM
WINDOW = 128
BLOCK_Q = 128
REL_BUCKETS = 32
REL_MAX_DIST = 128
DN_WIDTH = D_MODEL // 4
DN_HEADS = DN_WIDTH // HEAD_DIM
DN_DK = HEAD_DIM
DN_DV = HEAD_DIM
DN_QK = DN_HEADS * DN_DK
DN_CHUNK = 64
D_MIX = LRU_WIDTH + ATT_WIDTH + DN_WIDTH
IN_SPLITS = (LRU_WIDTH, LRU_WIDTH,
             ATT_WIDTH, KV_WIDTH, KV_WIDTH,
             DN_QK, DN_QK, DN_WIDTH, DN_WIDTH,
             DN_HEADS, DN_HEADS)
D_IN = sum(IN_SPLITS)

kernel_name = "hymba_style_lru_swa_deltanet_macaron"


def rms_norm(x, g):
    xf = x.astype(jnp.float32)
    y = xf * lax.rsqrt(jnp.mean(xf * xf, axis=-1, keepdims=True) + EPS)
    return (y * g.astype(jnp.float32)).astype(x.dtype)


def swiglu(x, w_gate, w_up, w_down):
    return (jax.nn.silu(x @ w_gate) * (x @ w_up)) @ w_down


def causal_dwconv(x, w, b=None):
    K = w.shape[0]
    S = x.shape[1]
    xp = jnp.pad(x, ((0, 0), (K - 1, 0), (0, 0)))
    y = xp[:, 0:S] * w[0]
    for k in range(1, K):
        y = y + xp[:, k:k + S] * w[k]
    if b is not None:
        y = y + b
    return y


def split_points():
    return np.cumsum(np.array(IN_SPLITS))[:-1].tolist()


def rg_lru(x, w_a, b_a, w_x, b_x, lam):
    B, S, _ = x.shape
    xb = x.reshape(B, S, LRU_BLOCKS, LRU_BLOCK)
    r = jax.nn.sigmoid(jnp.einsum('bshi,hij->bshj', xb, w_a).reshape(B, S, LRU_WIDTH) + b_a)
    i = jax.nn.sigmoid(jnp.einsum('bshi,hij->bshj', xb, w_x).reshape(B, S, LRU_WIDTH) + b_x)
    log_a = -LRU_C * r.astype(jnp.float32) * jax.nn.softplus(-lam.astype(jnp.float32))
    a = jnp.exp(log_a)
    u = jnp.sqrt(-jnp.expm1(2.0 * log_a)) * (i * x).astype(jnp.float32)

    def combine(left, right):
        a1, b1 = left
        a2, b2 = right
        return a1 * a2, a2 * b1 + b2

    _, h = lax.associative_scan(combine, (a, u), axis=1)
    return h.astype(x.dtype)


def rel_bucket(dist):
    max_exact = REL_BUCKETS // 2
    large = max_exact + (jnp.log(jnp.maximum(dist, 1).astype(jnp.float32) / max_exact)
                         / math.log(REL_MAX_DIST / max_exact)
                         * (REL_BUCKETS - max_exact)).astype(jnp.int32)
    large = jnp.minimum(large, REL_BUCKETS - 1)
    return jnp.where(dist < max_exact, dist, large)


def swa_attention(q, k, v, sinks, rel_bias):
    B, S = q.shape[:2]
    NB = S // BLOCK_Q
    qb = q.reshape(B, NB, BLOCK_Q, ATT_KV_HEADS, ATT_GROUP, HEAD_DIM)

    def with_prev(t):
        tb = t.reshape(B, NB, BLOCK_Q, ATT_KV_HEADS, HEAD_DIM)
        prev = jnp.pad(tb, ((0, 0), (1, 0), (0, 0), (0, 0), (0, 0)))[:, :-1]
        return jnp.concatenate([prev, tb], axis=2)

    kb, vb = with_prev(k), with_prev(v)
    qi = jnp.arange(BLOCK_Q)[:, None]
    kj = jnp.arange(2 * BLOCK_Q)[None, :]
    dist = BLOCK_Q + qi - kj
    band = (dist >= 0) & (dist < WINDOW)
    blk = jnp.arange(NB)[:, None, None]
    valid = band[None] & ((blk > 0) | (kj[None] >= BLOCK_Q))
    bias = rel_bias.astype(jnp.float32)[rel_bucket(jnp.maximum(dist, 0))]
    bias = bias.transpose(2, 0, 1).reshape(ATT_KV_HEADS, ATT_GROUP, BLOCK_Q, 2 * BLOCK_Q)
    s = jnp.einsum('bnikgd,bnjkd->bnkgij', qb, kb).astype(jnp.float32) * (HEAD_DIM ** -0.5) + bias
    s = jnp.where(valid[None, :, None, None], s, -jnp.inf)
    sink = sinks.astype(jnp.float32).reshape(ATT_KV_HEADS, ATT_GROUP)[:, :, None, None]
    m = jnp.maximum(jnp.max(s, axis=-1, keepdims=True), sink)
    e = jnp.exp(s - m)
    probs = e / (jnp.sum(e, axis=-1, keepdims=True) + jnp.exp(sink - m))
    o = jnp.einsum('bnkgij,bnjkd->bnikgd', probs.astype(v.dtype), vb)
    return o.reshape(B, S, ATT_WIDTH)


def l2norm(t):
    return t * lax.rsqrt(jnp.sum(t * t, axis=-1, keepdims=True) + EPS)


def gated_delta_rule(q, k, v, g, beta):
    B, S, H, DK = k.shape
    DV = v.shape[-1]
    C = DN_CHUNK
    NC = S // C
    f32 = jnp.float32
    q = l2norm(q.astype(f32)) * (DK ** -0.5)
    k = l2norm(k.astype(f32))

    def chunks(t):
        return t.reshape(B, NC, C, H, -1).transpose(1, 0, 3, 2, 4)

    qc, kc, vc = chunks(q), chunks(k), chunks(v.astype(f32))
    gc = g.astype(f32).reshape(B, NC, C, H).transpose(1, 0, 3, 2)
    bc = beta.astype(f32).reshape(B, NC, C, H).transpose(1, 0, 3, 2)
    gcum = jnp.cumsum(gc, axis=-1)
    tril = jnp.tril(jnp.ones((C, C), dtype=bool))
    strict = jnp.tril(jnp.ones((C, C), dtype=bool), -1)
    decay = jnp.exp(jnp.where(tril, gcum[..., :, None] - gcum[..., None, :], -jnp.inf))
    k_beta = kc * bc[..., None]
    v_beta = vc * bc[..., None]
    Lmat = jnp.where(strict, jnp.einsum('...id,...jd->...ij', k_beta, kc) * decay, 0.0)
    eye = jnp.eye(C, dtype=f32)
    T = lax.linalg.triangular_solve(Lmat + eye, jnp.broadcast_to(eye, Lmat.shape),
                                    left_side=True, lower=True, unit_diagonal=True)
    u = jnp.einsum('...ij,...jd->...id', T, v_beta)
    w = jnp.einsum('...ij,...jd->...id', T, k_beta * jnp.exp(gcum)[..., None])

    def step(state, xs):
        q_i, k_i, u_i, w_i, g_i, dec_i = xs
        attn = jnp.einsum('bhid,bhjd->bhij', q_i, k_i) * dec_i
        v_new = u_i - jnp.einsum('bhcd,bhde->bhce', w_i, state)
        o = (jnp.einsum('bhcd,bhde->bhce', q_i * jnp.exp(g_i)[..., None], state)
             + jnp.einsum('bhij,bhje->bhie', attn, v_new))
        g_last = g_i[..., -1]
        k_dec = k_i * jnp.exp(g_last[..., None] - g_i)[..., None]
        state = state * jnp.exp(g_last)[..., None, None] + jnp.einsum('bhcd,bhce->bhde', k_dec, v_new)
        return state, o

    state0 = jnp.zeros((B, H, DK, DV), f32)
    _, o = lax.scan(step, state0, (qc, kc, u, w, gcum, decay))
    return o.transpose(1, 0, 3, 2, 4).reshape(B, S, H, DV)


def hybrid_mixer(xn, w_in, lru_conv_w, lru_conv_b, lru_w_a, lru_b_a, lru_w_x, lru_b_x, lru_lambda,
                 attn_sinks, rel_bias, dn_conv_w, dn_a_log, dn_dt_bias, dn_norm, w_out):
    B, S, _ = xn.shape
    u = xn @ w_in
    (lru_x, lru_gate, att_q, att_k, att_v, dn_q, dn_k, dn_v, dn_z, dn_b, dn_a) = jnp.split(
        u, split_points(), axis=-1)
    xr = causal_dwconv(lru_x, lru_conv_w, lru_conv_b)
    y_lru = jax.nn.gelu(lru_gate) * rg_lru(xr, lru_w_a, lru_b_a, lru_w_x, lru_b_x, lru_lambda)
    y_att = swa_attention(att_q.reshape(B, S, ATT_HEADS, HEAD_DIM),
                          att_k.reshape(B, S, ATT_KV_HEADS, HEAD_DIM),
                          att_v.reshape(B, S, ATT_KV_HEADS, HEAD_DIM),
                          attn_sinks, rel_bias)
    qkv = jax.nn.silu(causal_dwconv(jnp.concatenate([dn_q, dn_k, dn_v], axis=-1), dn_conv_w))
    q, k, v = jnp.split(qkv, [DN_QK, 2 * DN_QK], axis=-1)
    beta = jax.nn.sigmoid(dn_b.astype(jnp.float32))
    g = -jnp.exp(dn_a_log.astype(jnp.float32)) * jax.nn.softplus(
        dn_a.astype(jnp.float32) + dn_dt_bias.astype(jnp.float32))
    o = gated_delta_rule(q.reshape(B, S, DN_HEADS, DN_DK), k.reshape(B, S, DN_HEADS, DN_DK),
                         v.reshape(B, S, DN_HEADS, DN_DV), g, beta)
    z = dn_z.reshape(B, S, DN_HEADS, DN_DV).astype(jnp.float32)
    o = (o * lax.rsqrt(jnp.mean(o * o, axis=-1, keepdims=True) + EPS)
         * dn_norm.astype(jnp.float32) * jax.nn.silu(z))
    y_dn = o.reshape(B, S, DN_WIDTH).astype(xn.dtype)
    return jnp.concatenate([y_lru, y_att, y_dn], axis=-1) @ w_out


def setup_inputs(seed: int = 0) -> dict:
    key = jax.random.key(seed)
    ks = list(jax.random.split(key, 48))

    def nrm(shape, scale):
        return scale * jax.random.normal(ks.pop(), shape, jnp.float32)

    def gain(shape):
        return 1.0 + 0.02 * jax.random.normal(ks.pop(), shape, jnp.float32)

    L, D = DEPTH, D_MODEL
    x = nrm((BATCH, SEQ, D), 1.0)
    p = nrm((DEPTH, BATCH, SEQ, PLE_DIM), 1.0)
    a_c = jax.random.uniform(ks.pop(), (L, LRU_WIDTH), jnp.float32, 0.9, 0.999)
    s = a_c ** (1.0 / LRU_C)
    lru_lambda = jnp.log(s) - jnp.log1p(-s)
    dn_a_log = jnp.log(jax.random.uniform(ks.pop(), (L, DN_HEADS), jnp.float32, 1.0, 16.0))
    dt = jnp.exp(jax.random.uniform(ks.pop(), (L, DN_HEADS), jnp.float32,
                                    math.log(1e-3), math.log(1e-1)))
    dn_dt_bias = dt + jnp.log(-jnp.expm1(-dt))
    return {
        "x": x,
        "p": p,
        "ffn1_norm": gain((L, D)),
        "ffn1_w_gate": nrm((L, D, D_FF), D ** -0.5),
        "ffn1_w_up": nrm((L, D, D_FF), D ** -0.5),
        "ffn1_w_down": nrm((L, D_FF, D), D_FF ** -0.5),
        "mix_norm": gain((L, D)),
        "w_in": nrm((L, D, D_IN), D ** -0.5),
        "lru_conv_w": nrm((L, CONV_W, LRU_WIDTH), CONV_W ** -0.5),
        "lru_conv_b": nrm((L, LRU_WIDTH), 0.01),
        "lru_w_a": nrm((L, LRU_BLOCKS, LRU_BLOCK, LRU_BLOCK), LRU_BLOCK ** -0.5),
        "lru_b_a": nrm((L, LRU_WIDTH), 0.01),
        "lru_w_x": nrm((L, LRU_BLOCKS, LRU_BLOCK, LRU_BLOCK), LRU_BLOCK ** -0.5),
        "lru_b_x": nrm((L, LRU_WIDTH), 0.01),
        "lru_lambda": lru_lambda,
        "attn_sinks": nrm((L, ATT_HEADS), 0.5),
        "rel_bias": nrm((REL_BUCKETS, ATT_HEADS), 0.5),
        "dn_conv_w": nrm((L, CONV_W, 2 * DN_QK + DN_WIDTH), CONV_W ** -0.5),
        "dn_a_log": dn_a_log,
        "dn_dt_bias": dn_dt_bias,
        "dn_norm": gain((L, DN_DV)),
        "w_out": nrm((L, D_MIX, D), D_MIX ** -0.5),
        "ffn2_norm": gain((L, D)),
        "ffn2_w_gate": nrm((L, D, D_FF), D ** -0.5),
        "ffn2_w_up": nrm((L, D, D_FF), D ** -0.5),
        "ffn2_w_down": nrm((L, D_FF, D), D_FF ** -0.5),
        "ple_norm": gain((L, D)),
        "ple_w_gate": nrm((L, D, D), D ** -0.5),
        "ple_w_proj": nrm((L, PLE_DIM, D), PLE_DIM ** -0.5),
        "final_norm": gain((D,)),
    }


def reference(x, p, ffn1_norm, ffn1_w_gate, ffn1_w_up, ffn1_w_down, mix_norm, w_in,
              lru_conv_w, lru_conv_b, lru_w_a, lru_b_a, lru_w_x, lru_b_x, lru_lambda,
              attn_sinks, rel_bias, dn_conv_w, dn_a_log, dn_dt_bias, dn_norm, w_out,
              ffn2_norm, ffn2_w_gate, ffn2_w_up, ffn2_w_down, ple_norm, ple_w_gate, ple_w_proj,
              final_norm):
    h = x
    for l in range(DEPTH):
        h = h + 0.5 * swiglu(rms_norm(h, ffn1_norm[l]), ffn1_w_gate[l], ffn1_w_up[l], ffn1_w_down[l])
        h = h + hybrid_mixer(rms_norm(h, mix_norm[l]), w_in[l],
                             lru_conv_w[l], lru_conv_b[l], lru_w_a[l], lru_b_a[l],
                             lru_w_x[l], lru_b_x[l], lru_lambda[l],
                             attn_sinks[l], rel_bias,
                             dn_conv_w[l], dn_a_log[l], dn_dt_bias[l], dn_norm[l], w_out[l])
        h = h + 0.5 * swiglu(rms_norm(h, ffn2_norm[l]), ffn2_w_gate[l], ffn2_w_up[l], ffn2_w_down[l])
        gate = jax.nn.sigmoid(rms_norm(h, ple_norm[l]) @ ple_w_gate[l])
        h = h + gate * (p[l] @ ple_w_proj[l])
    return rms_norm(h, final_norm)
```

```cpp
#include <hip/hip_runtime.h>
#include <hip/hip_cooperative_groups.h>
#include <cstdio>
#include <cstdint>
namespace cg = cooperative_groups;
namespace pg8 {
#define PG8_LAS __attribute__((address_space(3)))
typedef unsigned short bf16_t;
typedef short bf16x8 __attribute__((ext_vector_type(8)));
typedef float f32x4 __attribute__((ext_vector_type(4)));
typedef unsigned u32x4 __attribute__((ext_vector_type(4)));
constexpr int BM = 256, BK = 64, HALF = 128, HTB = HALF * BK * 2  , STAGE_BYTES = 8 * HTB, NXCD = 8, WGM = 8;

__host__ __device__ __forceinline__ int lds_byte(int r, int c) { const int st = (r >> 4) * 2 + (c >> 5), rr = r & 15, cc = c & 31, ob = rr * 64 + cc * 2; return st * 1024 + (ob ^ (((ob >> 9) & 1) << 5)); }
__host__ __device__ __forceinline__ void stage_rc(int b, int& R, int& C) { const int st = b / 1024, sb = b % 1024, swz = sb ^ (((sb >> 9) & 1) << 5); R = (st >> 1) * 16 + swz / 64; C = (st & 1) * 32 + (swz % 64) / 2; }
__host__ __device__ __forceinline__ int perm32(int rho) { const int n = rho >> 4, i = rho & 15; return 8 * (i >> 2) + 4 * n + (i & 3); }

struct Unit { int pm, pn; };
struct Gemm { const bf16_t* A; const bf16_t* Bt; int M, N, K; };

struct StaticOrder {
    int nM, nN, nwg, G, c, rev;
    __host__ __device__ void init(int M, int N, int G_, int c_, int rev_ = 0) { nM = M / BM; nN = N / BM; nwg = nM * nN; G = G_; c = c_; rev = rev_; }
    __host__ __device__ bool next(int i, Unit& u) const {
        const long L = (long)i * G + c; if (L >= nwg) return false;
        int wgid = (int)L; { const int q = nwg / NXCD, r = nwg % NXCD, xcd = wgid % NXCD, off = wgid / NXCD; wgid = (xcd < r ? xcd * (q + 1) : r * (q + 1) + (xcd - r) * q) + off; }
        const int nig = WGM * nN, gid = wgid / nig, fm = gid * WGM, gsz = (nM - fm) < WGM ? (nM - fm) : WGM;
        u.pm = fm + ((wgid % nig) % gsz); u.pn = (wgid % nig) / gsz; if (rev) u.pm = nM - 1 - u.pm; return true;
    }
    __device__ __forceinline__ void a_ready(const Unit&) const {}
    __device__ __forceinline__ void done(const Unit&) const {}
};

__device__ __forceinline__ unsigned cvt_pk_bf16(float lo, float hi) { unsigned r; asm volatile("v_cvt_pk_bf16_f32 %0, %1, %2" : "=v"(r) : "v"(lo), "v"(hi)); return r; }
template <class Epi, class Sched, bool ALIGN_EPI = false, bool SP2 = false>
__device__ __forceinline__ void gemm_phase(PG8_LAS unsigned char* lds, const Gemm g, const Sched& S, const Epi& E) {
    int tid_ = threadIdx.x; asm volatile("" : "+v"(tid_));
    const int tid = tid_, wid = __builtin_amdgcn_readfirstlane(tid >> 6), lane = tid & 63, wr = wid >> 2, wc = wid & 3, fr = lane & 15, fq = lane >> 4;
    const int K = g.K, nt = K / BK;
    unsigned voffA[2], voffB[2];
#pragma unroll
    for (int i = 0; i < 2; ++i) { int R, C; stage_rc(tid * 16 + i * 8192, R, C); const int Rb = Epi::PERM ? ((R & ~31) + perm32(R & 31)) : R;
        voffA[i] = (unsigned)(R * K + C) * 2u; voffB[i] = (unsigned)(Rb * K + C) * 2u; }
    const size_t kstep = (size_t)(BK * 2);
    const size_t hstep = (size_t)HALF * K * 2;
    const size_t tstep = 2 * hstep;
    const unsigned ldsw = (unsigned)wid * 1024u;
    const int aoff = lds_byte(wr * 64 + fr, fq * 8), boff = lds_byte(wc * 32 + fr, fq * 8);
#define PG8_SA(b, h) (((b) * 2 + (h)) * HTB)
#define PG8_SB(b, h) ((4 + (b) * 2 + (h)) * HTB)
#define PG8_STAGE(bufoff, gbase, voff) do { _Pragma("unroll") for (int _i = 0; _i < 2; ++_i) \
        __builtin_amdgcn_global_load_lds((const unsigned*)((const char*)(gbase) + (voff)[_i]), (PG8_LAS unsigned*)(lds + (bufoff) + ldsw + _i * 8192), 16, 0, 0); } while (0)
#define PG8_LDA(dst, b, h) do { _Pragma("unroll") for (int m = 0; m < 4; ++m) _Pragma("unroll") for (int k = 0; k < 2; ++k) dst[m][k] = *(const PG8_LAS bf16x8*)(lds + PG8_SA(b, h) + aoff + m * 2048 + k * 1024); } while (0)
#define PG8_LDB(dst, b, h) do { _Pragma("unroll") for (int n = 0; n < 2; ++n) _Pragma("unroll") for (int k = 0; k < 2; ++k) dst[n][k] = *(const PG8_LAS bf16x8*)(lds + PG8_SB(b, h) + boff + n * 2048 + k * 1024); } while (0)
#define PG8_MMA(ai, bj, At, Bt) do { __builtin_amdgcn_s_setprio(1); _Pragma("unroll") for (int m = 0; m < 4; ++m) _Pragma("unroll") for (int n = 0; n < 2; ++n) _Pragma("unroll") for (int k = 0; k < 2; ++k) \
        acc[ai][bj][m][n] = __builtin_amdgcn_mfma_f32_16x16x32_bf16(Bt[n][k], At[m][k], acc[ai][bj][m][n], 0, 0, 0); __builtin_amdgcn_s_setprio(0); } while (0)
#define PG8_WAIT_V(n) asm volatile("s_waitcnt vmcnt(" #n ")" ::: "memory")
#define PG8_WAIT_L(n) asm volatile("s_waitcnt lgkmcnt(" #n ")" ::: "memory")
#define PG8_BAR __builtin_amdgcn_s_barrier()
#define PG8_SCHED __builtin_amdgcn_sched_barrier(0)
    Unit cur, nxt; int ui = 0;
    if (!S.next(0, cur)) return;
    f32x4 acc[2][2][4][2];
#pragma unroll
    for (int a = 0; a < 2; ++a)
#pragma unroll
        for (int b = 0; b < 2; ++b)
#pragma unroll
            for (int m = 0; m < 4; ++m)
#pragma unroll
                for (int n = 0; n < 2; ++n) acc[a][b][m][n] = (f32x4){0.f, 0.f, 0.f, 0.f};
    bf16x8 At[4][2], B0[2][2], B1[2][2];
    const char* cA = (const char*)g.A + (size_t)cur.pm * tstep; const char* cB = (const char*)g.Bt + (size_t)cur.pn * tstep;
    S.a_ready(cur);
    if constexpr (SP2) {
        PG8_STAGE(PG8_SB(0, 0), cB, voffB); PG8_STAGE(PG8_SB(0, 1), cB + hstep, voffB); PG8_STAGE(PG8_SA(0, 0), cA, voffA); PG8_STAGE(PG8_SA(0, 1), cA + hstep, voffA);
        if (wr == 1) PG8_BAR;
        PG8_WAIT_V(2); PG8_BAR;
        PG8_STAGE(PG8_SB(1, 0), cB + kstep, voffB); PG8_STAGE(PG8_SA(1, 0), cA + kstep, voffA); PG8_STAGE(PG8_SB(1, 1), cB + hstep + kstep, voffB);
        PG8_WAIT_V(6); PG8_BAR;
    } else {
        PG8_STAGE(PG8_SB(0, 0), cB, voffB); PG8_STAGE(PG8_SA(0, 0), cA, voffA); PG8_STAGE(PG8_SB(0, 1), cB + hstep, voffB); PG8_STAGE(PG8_SA(0, 1), cA + hstep, voffA);
        if (wr == 1) PG8_BAR;
        PG8_WAIT_V(4); PG8_BAR;
        PG8_STAGE(PG8_SB(1, 0), cB + kstep, voffB); PG8_STAGE(PG8_SA(1, 0), cA + kstep, voffA); PG8_STAGE(PG8_SB(1, 1), cB + hstep + kstep, voffB);
        PG8_WAIT_V(6); PG8_BAR;
    }
    for (;;) {
        const bool has_next = S.next(ui + 1, nxt);
        const char* nA = has_next ? (const char*)g.A + (size_t)nxt.pm * tstep : cA; const char* nB = has_next ? (const char*)g.Bt + (size_t)nxt.pn * tstep : cB;
        for (int t = 0; t < nt; t += 2) {
            const bool last = (t == nt - 2);
            const char* a1 = cA + (size_t)(t + 1) * kstep;
            const char* a2 = last ? nA : cA + (size_t)(t + 2) * kstep; const char* b2 = last ? nB : cB + (size_t)(t + 2) * kstep;
            const char* a3 = a2 + kstep; const char* b3 = b2 + kstep;
            if (last && has_next) S.a_ready(nxt);
            if constexpr (SP2) {
            PG8_LDB(B0, 0, 0); PG8_LDB(B1, 0, 1); PG8_SCHED; PG8_LDA(At, 0, 0); PG8_STAGE(PG8_SA(1, 1), a1 + hstep, voffA);
            PG8_WAIT_V(8); PG8_WAIT_L(0); PG8_BAR; PG8_MMA(0, 0, At, B0); PG8_MMA(0, 1, At, B1); PG8_BAR; PG8_SCHED;
            PG8_LDA(At, 0, 1); PG8_STAGE(PG8_SB(0, 0), b2, voffB); PG8_STAGE(PG8_SB(0, 1), b2 + hstep, voffB); PG8_STAGE(PG8_SA(0, 0), a2, voffA);
            PG8_WAIT_V(8); PG8_WAIT_L(0); PG8_BAR; PG8_MMA(1, 0, At, B0); PG8_MMA(1, 1, At, B1); PG8_BAR; PG8_SCHED;
            PG8_LDB(B0, 1, 0); PG8_LDB(B1, 1, 1); PG8_SCHED; PG8_LDA(At, 1, 0); PG8_STAGE(PG8_SA(0, 1), a2 + hstep, voffA);
            PG8_WAIT_V(8); PG8_WAIT_L(0); PG8_BAR; PG8_MMA(0, 0, At, B0); PG8_MMA(0, 1, At, B1); PG8_BAR; PG8_SCHED;
            PG8_LDA(At, 1, 1); PG8_STAGE(PG8_SB(1, 0), b3, voffB); PG8_STAGE(PG8_SB(1, 1), b3 + hstep, voffB); PG8_STAGE(PG8_SA(1, 0), a3, voffA);
            PG8_WAIT_V(8); PG8_WAIT_L(0); PG8_BAR; PG8_MMA(1, 0, At, B0); PG8_MMA(1, 1, At, B1); PG8_BAR; PG8_SCHED;
            } else {
            PG8_LDB(B0, 0, 0); PG8_SCHED; PG8_LDA(At, 0, 0); PG8_STAGE(PG8_SA(1, 1), a1 + hstep, voffA);
            PG8_WAIT_L(8); PG8_BAR; PG8_WAIT_L(0); PG8_MMA(0, 0, At, B0); PG8_BAR; PG8_SCHED;
            PG8_LDB(B1, 0, 1); PG8_STAGE(PG8_SB(0, 0), b2, voffB);
            PG8_BAR; PG8_WAIT_L(0); PG8_MMA(0, 1, At, B1); PG8_BAR;
            PG8_LDA(At, 0, 1); PG8_STAGE(PG8_SA(0, 0), a2, voffA);
            PG8_BAR; PG8_WAIT_L(0); PG8_MMA(1, 0, At, B0); PG8_BAR; PG8_SCHED;
            PG8_STAGE(PG8_SB(0, 1), b2 + hstep, voffB);
            PG8_WAIT_V(6); PG8_BAR; PG8_MMA(1, 1, At, B1); PG8_BAR;
            PG8_LDB(B0, 1, 0); PG8_SCHED; PG8_LDA(At, 1, 0); PG8_STAGE(PG8_SA(0, 1), a2 + hstep, voffA);
            PG8_WAIT_L(8); PG8_BAR; PG8_WAIT_L(0); PG8_MMA(0, 0, At, B0); PG8_BAR; PG8_SCHED;
            PG8_LDB(B1, 1, 1); PG8_STAGE(PG8_SB(1, 0), b3, voffB);
            PG8_BAR; PG8_WAIT_L(0); PG8_MMA(0, 1, At, B1); PG8_BAR;
            PG8_LDA(At, 1, 1); PG8_STAGE(PG8_SA(1, 0), a3, voffA);
            PG8_BAR; PG8_WAIT_L(0); PG8_MMA(1, 0, At, B0); PG8_BAR; PG8_SCHED;
            PG8_STAGE(PG8_SB(1, 1), b3 + hstep, voffB);
            PG8_WAIT_V(6); PG8_BAR; PG8_MMA(1, 1, At, B1); PG8_BAR;
            }
        }
        if constexpr (ALIGN_EPI) { if (wr == 0) PG8_BAR; }
        if constexpr (!Epi::AFTER_DRAIN) { E(acc, cur, wr, wc, fr, fq); S.done(cur); }
        if (!has_next) break;
#pragma unroll
        for (int a = 0; a < 2; ++a)
#pragma unroll
            for (int b = 0; b < 2; ++b)
#pragma unroll
                for (int m = 0; m < 4; ++m)
#pragma unroll
                    for (int n = 0; n < 2; ++n) acc[a][b][m][n] = (f32x4){0.f, 0.f, 0.f, 0.f};
        cur = nxt; cA = nA; cB = nB; ++ui;
        if constexpr (ALIGN_EPI) { if (wr == 1) PG8_BAR; }
    }
    PG8_WAIT_V(0);
    if constexpr (!ALIGN_EPI) { if (wr == 0) PG8_BAR; }
    PG8_BAR;
    if constexpr (Epi::AFTER_DRAIN) { E.fused(acc, cur, wr, wc, fr, fq, lds, wid, lane); S.done(cur); }
#undef PG8_SA
#undef PG8_SB
#undef PG8_STAGE
#undef PG8_LDA
#undef PG8_LDB
#undef PG8_MMA
#undef PG8_WAIT_V
#undef PG8_WAIT_L
#undef PG8_BAR
#undef PG8_SCHED
}
}

#define LAS __attribute__((address_space(3)))
typedef pg8::bf16_t bf16_t;
typedef pg8::f32x4 f32x4;
typedef pg8::bf16x8 bf16x8;
typedef unsigned u32x4v __attribute__((ext_vector_type(4)));
typedef unsigned u32x2v __attribute__((ext_vector_type(2)));
typedef short s16x4 __attribute__((ext_vector_type(4)));
constexpr int NBATCH = 16, SEQ = 2048, T = NBATCH * SEQ, D = 1024, FF = 2816, DIN = 2312, NIN = 2560, PLE = 256, NL = 2;
constexpr int U_LRUX = 0, U_LRUG = 256, U_AQ = 512, U_AK = 1024, U_AV = 1152, U_DQ = 1280, U_DZ = 2048;
constexpr float EPS = 1e-6f;
constexpr int NTHR = 512, NWAVES = 8;
constexpr int LDS_BYTES = 147456;
constexpr size_t MiB = 1u << 20;
constexpr size_t SZ_GU = 5632ull * 1024 * 2, SZ_DN = 1024ull * 2816 * 2, SZ_IN = 2560ull * 1024 * 2, SZ_SQ = 1024ull * 1024 * 2, SZ_PP = 1024ull * 256 * 2, SZ_LRU = 2ull * 4 * 64 * 64 * 2;
constexpr size_t O_GU1 = 0, O_D1 = O_GU1 + SZ_GU, O_GU2 = O_D1 + SZ_DN, O_D2 = O_GU2 + SZ_GU, O_IN = O_D2 + SZ_DN, O_OUT = O_IN + SZ_IN, O_PG = O_OUT + SZ_SQ, O_PP = O_PG + SZ_SQ, O_LRU = O_PP + SZ_PP, W_LAYER = O_LRU + SZ_LRU;
constexpr size_t WS_W = 1 * MiB, WS_XN = 89 * MiB, WS_R1 = 153 * MiB, WS_R2 = 329 * MiB, WS_END = 512 * MiB;
static_assert(WS_W + NL * W_LAYER <= WS_XN, "weights fit");
static_assert((size_t)T * FF * 2 <= WS_R2 - WS_R1, "act fits R1");
constexpr size_t R2_LH = 0, R2_PC = 16 * MiB, R2_AGG = 32 * MiB, R2_DQ = 34 * MiB, R2_DK = 50 * MiB, R2_DV = 66 * MiB, R2_UU = 82 * MiB, R2_GG = 98 * MiB, R2_BE = 98 * MiB + 512 * 1024, R2_DNBA = 99 * MiB,
                 R2_WW = 100 * MiB, R2_QG = 116 * MiB, R2_ATT = 132 * MiB, R2_KDT = 148 * MiB, R2_EGL = 164 * MiB, R2_USED = 165 * MiB;
constexpr size_t R2_CARRY = 181 * MiB;
static_assert(WS_R2 + R2_CARRY + (size_t)NBATCH * 64 * 256 * 4 <= WS_END, "carry fits");
constexpr size_t WS_UU = WS_R1 + 160 * MiB;
constexpr size_t R2_PBF = 165 * MiB, R2_PBUF = 34 * MiB, R2_XB = 100 * MiB;
static_assert(WS_UU + (size_t)T * 256 * 2 <= WS_R2 && R2_PBUF + (size_t)T * D * 2 <= 98 * MiB && R2_XB + (size_t)T * D * 2 <= 164 * MiB, "map");
constexpr size_t WS_RSS = 87 * MiB;
static_assert(WS_W + NL * W_LAYER <= WS_RSS && WS_RSS + 2 * 4 * (size_t)T * 4 <= WS_XN && R2_PBF + (size_t)T * PLE * 2 <= WS_END - WS_R2, "map");
static_assert(WS_R2 + R2_USED <= WS_END, "R2 fits");

__device__ __forceinline__ float bf2f(unsigned short b) { return __uint_as_float(((unsigned)b) << 16); }
__device__ __forceinline__ float bflo(unsigned w) { return __uint_as_float(w << 16); }
__device__ __forceinline__ float bfhi(unsigned w) { return __uint_as_float(w & 0xffff0000u); }
__device__ __forceinline__ unsigned pk2(float lo, float hi) { return pg8::cvt_pk_bf16(lo, hi); }
__device__ __forceinline__ unsigned short f2bf(float f) { return (unsigned short)(pg8::cvt_pk_bf16(f, 0.f) & 0xffffu); }
__device__ __forceinline__ float sigmoidf_(float x) { return __builtin_amdgcn_rcpf(1.0f + __expf(-x)); }
__device__ __forceinline__ float siluf_(float x) { return x * __builtin_amdgcn_rcpf(1.0f + __expf(-x)); }
__device__ __forceinline__ float softplusf_(float x) { const float e = __expf(-fabsf(x)); const float lg = (e < 0.03f) ? e * (1.0f - e * (0.5f - e * (0.33333334f - 0.25f * e))) : __logf(1.0f + e); return fmaxf(x, 0.f) + lg; }
__device__ __forceinline__ float gelu_tanh(float x) { const float u2 = 1.5957691216057308f * (x + 0.044715f * x * x * x); return x * __builtin_amdgcn_rcpf(1.0f + __expf(-u2)); }
#define DPP_ADD(v, ctrl) do { const int _t = __builtin_amdgcn_update_dpp(0, __builtin_bit_cast(int, (v)), (ctrl), 0xf, 0xf, true); (v) += __builtin_bit_cast(float, _t); } while (0)
__device__ __forceinline__ float wave_sum(float v) {
    DPP_ADD(v, 0xB1); DPP_ADD(v, 0x4E); DPP_ADD(v, 0x141); DPP_ADD(v, 0x140);
    const int vi = __builtin_bit_cast(int, v);
    const float r0 = __builtin_bit_cast(float, __builtin_amdgcn_readlane(vi, 0)), r1 = __builtin_bit_cast(float, __builtin_amdgcn_readlane(vi, 16)), r2 = __builtin_bit_cast(float, __builtin_amdgcn_readlane(vi, 32)), r3 = __builtin_bit_cast(float, __builtin_amdgcn_readlane(vi, 48));
    return (r0 + r1) + (r2 + r3);
}

__device__ __forceinline__ float rstd_of(const float* rss, int row) { const f32x4 p = *(const f32x4*)(rss + (size_t)row * 4); return 1.0f / sqrtf(((p[0] + p[1]) + (p[2] + p[3])) * (1.0f / D) + EPS); }
constexpr int EPI_LDS_OFF = 131072;
using pg8::Unit;
struct EpiSwiglu {
    static constexpr bool PERM = true, AFTER_DRAIN = false;
    bf16_t* O_; const float* rss_;
    __device__ __forceinline__ void operator()(const f32x4 (&acc)[2][2][4][2], const Unit& u, int wr, int wc, int fr, int fq) const {
        bf16_t* O = O_; const float* rss = rss_; asm volatile("" : "+s"(O), "+s"(rss));
        const int row0 = u.pm * 256 + wr * 64 + fr, col0 = u.pn * 128 + wc * 32 + 8 * fq;
        float rsv[2][4];
        { f32x4 pp[2][4];
#pragma unroll
          for (int ai = 0; ai < 2; ++ai)
#pragma unroll
            for (int m = 0; m < 4; ++m) pp[ai][m] = *(const f32x4*)(rss + (size_t)(row0 + ai * 128 + m * 16) * 4);
#pragma unroll
          for (int ai = 0; ai < 2; ++ai)
#pragma unroll
            for (int m = 0; m < 4; ++m) rsv[ai][m] = __builtin_amdgcn_rsqf(((pp[ai][m][0] + pp[ai][m][1]) + (pp[ai][m][2] + pp[ai][m][3])) * (1.0f / D) + EPS); }
#pragma unroll
        for (int ai = 0; ai < 2; ++ai)
#pragma unroll
            for (int m = 0; m < 4; ++m) {
                bf16_t* rowp = O + (size_t)(row0 + ai * 128 + m * 16) * FF + col0;
                const float rs = rsv[ai][m];
                float v[8];
#pragma unroll
                for (int n = 0; n < 2; ++n)
#pragma unroll
                    for (int j = 0; j < 4; ++j) { const float g = acc[ai][0][m][n][j] * rs, up = acc[ai][1][m][n][j] * rs; v[n * 4 + j] = g * __builtin_amdgcn_rcpf(1.0f + __expf(-g)) * up; }
                u32x4v w; w.x = pk2(v[0], v[1]); w.y = pk2(v[2], v[3]); w.z = pk2(v[4], v[5]); w.w = pk2(v[6], v[7]);
                *(u32x4v*)rowp = w;
            }
    }
};
struct EpiResid {
    static constexpr bool PERM = false, AFTER_DRAIN = false;
    const bf16_t* in_; bf16_t* out_; float scale_; float* rss_; LAS float* part;
    __device__ __forceinline__ void operator()(const f32x4 (&acc)[2][2][4][2], const Unit& u, int wr, int wc, int fr, int fq) const {
        const bf16_t* in = in_; bf16_t* out = out_; float scale = scale_; float* rss = rss_;
        asm volatile("" : "+s"(in), "+s"(out), "+s"(scale), "+s"(rss));
        const int row0 = u.pm * 256 + wr * 64 + fr, col0 = u.pn * 256 + wc * 32 + 4 * fq;
#pragma unroll
        for (int hb = 0; hb < 2; ++hb) {
            u32x2v rin[4][4];
#pragma unroll
            for (int gg = 0; gg < 4; ++gg) { const int g = hb * 4 + gg; const size_t offn = (size_t)(row0 + (g >> 2) * 128 + (g & 3) * 16) * D + col0;
#pragma unroll
                for (int k = 0; k < 4; ++k) rin[gg][k] = *(const u32x2v*)(in + offn + (k >> 1) * 128 + (k & 1) * 16); }
#pragma unroll
            for (int gg = 0; gg < 4; ++gg) {
                const int g = hb * 4 + gg, ai = g >> 2, m = g & 3, row = row0 + ai * 128 + m * 16;
                const size_t off = (size_t)row * D + col0;
                float ss = 0.f;
#pragma unroll
                for (int k = 0; k < 4; ++k) { const int bj = k >> 1, n = k & 1; const size_t o = off + bj * 128 + n * 16; const f32x4 a = acc[ai][bj][m][n] * scale; const u32x2v w0 = rin[gg][k];
                    f32x4 r; r[0] = bflo(w0.x) + a[0]; r[1] = bfhi(w0.x) + a[1]; r[2] = bflo(w0.y) + a[2]; r[3] = bfhi(w0.y) + a[3];
                    u32x2v w; w.x = pk2(r[0], r[1]); w.y = pk2(r[2], r[3]); *(u32x2v*)(out + o) = w; ss += (r[0] * r[0] + r[1] * r[1]) + (r[2] * r[2] + r[3] * r[3]); }
                ss += __shfl_xor(ss, 16); ss += __shfl_xor(ss, 32);
                if (fq == 0) part[(ai * 128 + wr * 64 + m * 16 + fr) * 4 + wc] = ss;
            }
        }
        asm volatile("s_waitcnt lgkmcnt(0)" ::: "memory"); __builtin_amdgcn_s_barrier(); asm volatile("" ::: "memory");
        { int t = threadIdx.x; asm volatile("" : "+v"(t)); if (t < 256) { const f32x4 p = *(const LAS f32x4*)(part + t * 4); rss[(size_t)(u.pm * 256 + t) * 4 + u.pn] = (p[0] + p[1]) + (p[2] + p[3]); } }
    }
};
template <int LD, bool SIDE> struct EpiBf16 {
    static constexpr bool PERM = true, AFTER_DRAIN = false;
    bf16_t* O_; float* side_; const float* rss_;
    __device__ __forceinline__ void operator()(const f32x4 (&acc)[2][2][4][2], const Unit& u, int wr, int wc, int fr, int fq) const {
        bf16_t* O = O_; float* side = side_; const float* rss = rss_; asm volatile("" : "+s"(O), "+s"(side), "+s"(rss));
        const int row0 = u.pm * 256 + wr * 64 + fr, col0 = u.pn * 256 + wc * 32 + 8 * fq;
        float rsv[2][4];
        if (SIDE) { f32x4 pp[2][4];
#pragma unroll
          for (int ai = 0; ai < 2; ++ai)
#pragma unroll
            for (int m = 0; m < 4; ++m) pp[ai][m] = *(const f32x4*)(rss + (size_t)(row0 + ai * 128 + m * 16) * 4);
#pragma unroll
          for (int ai = 0; ai < 2; ++ai)
#pragma unroll
            for (int m = 0; m < 4; ++m) rsv[ai][m] = __builtin_amdgcn_rsqf(((pp[ai][m][0] + pp[ai][m][1]) + (pp[ai][m][2] + pp[ai][m][3])) * (1.0f / D) + EPS); }
#pragma unroll
        for (int ai = 0; ai < 2; ++ai)
#pragma unroll
            for (int m = 0; m < 4; ++m) {
                const int row = row0 + ai * 128 + m * 16;
                bf16_t* rowp = O + (size_t)row * LD + col0;
                const float rs = SIDE ? rsv[ai][m] : 1.0f;
#pragma unroll
                for (int bj = 0; bj < 2; ++bj) {
                    const f32x4 v0 = acc[ai][bj][m][0] * rs, v1 = acc[ai][bj][m][1] * rs;
                    u32x4v w; w.x = pk2(v0[0], v0[1]); w.y = pk2(v0[2], v0[3]); w.z = pk2(v1[0], v1[1]); w.w = pk2(v1[2], v1[3]);
                    *(u32x4v*)(rowp + bj * 128) = w;
                    if (SIDE) { if (bj == 0 && u.pn == 9 && wc == 0 && fq == 0) { *(f32x4*)(side + (size_t)row * 8) = v0; *(f32x4*)(side + (size_t)row * 8 + 4) = v1; } }
                }
            }
    }
};
struct EpiPle {
    static constexpr bool PERM = false, AFTER_DRAIN = false;
    const bf16_t* in_; bf16_t* out_; const bf16_t* P_; const float* rss_; float* rss_out_; LAS float* part;
    __device__ __forceinline__ void operator()(const f32x4 (&acc)[2][2][4][2], const Unit& u, int wr, int wc, int fr, int fq) const {
        const bf16_t* in = in_; bf16_t* out = out_; const bf16_t* P = P_; const float* rss = rss_; float* rss_out = rss_out_;
        asm volatile("" : "+s"(in), "+s"(out), "+s"(P), "+s"(rss), "+s"(rss_out));
        const int row0 = u.pm * 256 + wr * 64 + fr, col0 = u.pn * 256 + wc * 32 + 4 * fq;
        float rsv[8];
        { f32x4 pp[8];
#pragma unroll
          for (int g = 0; g < 8; ++g) pp[g] = *(const f32x4*)(rss + (size_t)(row0 + (g >> 2) * 128 + (g & 3) * 16) * 4);
#pragma unroll
          for (int g = 0; g < 8; ++g) rsv[g] = __builtin_amdgcn_rsqf(((pp[g][0] + pp[g][1]) + (pp[g][2] + pp[g][3])) * (1.0f / D) + EPS); }
#pragma unroll
        for (int hb = 0; hb < 4; ++hb) {
            u32x2v rin[2][4], pin[2][4];
#pragma unroll
            for (int gg = 0; gg < 2; ++gg) { const int g = hb * 2 + gg; const size_t offn = (size_t)(row0 + (g >> 2) * 128 + (g & 3) * 16) * D + col0;
#pragma unroll
                for (int k = 0; k < 4; ++k) { const size_t o = offn + (k >> 1) * 128 + (k & 1) * 16; rin[gg][k] = *(const u32x2v*)(in + o); pin[gg][k] = *(const u32x2v*)(P + o); } }
#pragma unroll
            for (int gg = 0; gg < 2; ++gg) {
                const int g = hb * 2 + gg, ai = g >> 2, m = g & 3, row = row0 + ai * 128 + m * 16;
                const size_t off = (size_t)row * D + col0;
                const float rs = rsv[g];
                float ss = 0.f;
#pragma unroll
                for (int k = 0; k < 4; ++k) { const int bj = k >> 1, n = k & 1; const size_t o = off + bj * 128 + n * 16;
                    const u32x2v rw = rin[gg][k], pw = pin[gg][k]; const f32x4 a = acc[ai][bj][m][n] * rs;
                    f32x4 res; res[0] = bflo(rw.x) + sigmoidf_(a[0]) * bflo(pw.x); res[1] = bfhi(rw.x) + sigmoidf_(a[1]) * bfhi(pw.x); res[2] = bflo(rw.y) + sigmoidf_(a[2]) * bflo(pw.y); res[3] = bfhi(rw.y) + sigmoidf_(a[3]) * bfhi(pw.y);
                    u32x2v w; w.x = pk2(res[0], res[1]); w.y = pk2(res[2], res[3]); *(u32x2v*)(out + o) = w; ss += (res[0] * res[0] + res[1] * res[1]) + (res[2] * res[2] + res[3] * res[3]); }
                ss += __shfl_xor(ss, 16); ss += __shfl_xor(ss, 32); if (fq == 0) part[(ai * 128 + wr * 64 + m * 16 + fr) * 4 + wc] = ss;
            }
        }
        asm volatile("s_waitcnt lgkmcnt(0)" ::: "memory"); __builtin_amdgcn_s_barrier(); asm volatile("" ::: "memory");
        { int t = threadIdx.x; asm volatile("" : "+v"(t)); if (t < 256) { const f32x4 p = *(const LAS f32x4*)(part + t * 4); rss_out[(size_t)(u.pm * 256 + t) * 4 + u.pn] = (p[0] + p[1]) + (p[2] + p[3]); } }
    }
};

struct ConvItem { const float* W; const float* gain; bf16_t* WT; int N, ldk, drow0, k0, n0; };
constexpr int CONV_PER_LAYER = 4 * 16 * 88 + 2 * 44 * 32 + 16 * 80 + 2 * 16 * 32 + 4 * 32 + 2 * 8;
__device__ __forceinline__ ConvItem conv_decode(const float* const* in, unsigned char* ws, int it) {
    constexpr int I_GU = 16 * 88, I_DN = 44 * 32, I_IN = 16 * 80, I_SQ = 16 * 32, I_PP = 4 * 32, I_LR = 8;
    static_assert(4 * I_GU + 2 * I_DN + I_IN + 2 * I_SQ + I_PP + 2 * I_LR == CONV_PER_LAYER, "items");
    const int l = it / CONV_PER_LAYER; int r = it % CONV_PER_LAYER;
    unsigned char* wl = ws + WS_W + (size_t)l * W_LAYER;
    ConvItem c;
    if (r < 4 * I_GU) {
        const int which = r / I_GU; r %= I_GU;
        const int kb = r / 88, nb = r % 88, n0 = nb * 32;
        c.W = in[which == 0 ? 3 : which == 1 ? 4 : which == 2 ? 23 : 24] + (size_t)l * D * FF; c.gain = in[which < 2 ? 2 : 22] + l * D; c.WT = (bf16_t*)(wl + (which < 2 ? O_GU1 : O_GU2));
        c.N = FF; c.ldk = D; c.drow0 = (n0 / 128) * 256 + (n0 % 128) + (which & 1) * 128; c.k0 = kb * 64; c.n0 = n0; return c; }
    r -= 4 * I_GU;
    if (r < 2 * I_DN) { const int which = r / I_DN; r %= I_DN; const int kb = r / 32, nb = r % 32;
        c.W = in[which == 0 ? 5 : 25] + (size_t)l * FF * D; c.gain = nullptr; c.WT = (bf16_t*)(wl + (which == 0 ? O_D1 : O_D2)); c.N = D; c.ldk = FF; c.drow0 = nb * 32; c.k0 = kb * 64; c.n0 = nb * 32; return c; }
    r -= 2 * I_DN;
    if (r < I_IN) { const int kb = r / 80, nb = r % 80;
        c.W = in[7] + (size_t)l * D * DIN; c.gain = in[6] + l * D; c.WT = (bf16_t*)(wl + O_IN); c.N = DIN; c.ldk = D; c.drow0 = nb * 32; c.k0 = kb * 64; c.n0 = nb * 32; return c; }
    r -= I_IN;
    if (r < 2 * I_SQ) { const int which = r / I_SQ; r %= I_SQ; const int kb = r / 32, nb = r % 32;
        c.W = in[which == 0 ? 21 : 27] + (size_t)l * D * D; c.gain = which == 0 ? nullptr : in[26] + l * D; c.WT = (bf16_t*)(wl + (which == 0 ? O_OUT : O_PG)); c.N = D; c.ldk = D; c.drow0 = nb * 32; c.k0 = kb * 64; c.n0 = nb * 32; return c; }
    r -= 2 * I_SQ;
    if (r < I_PP) { const int kb = r / 32, nb = r % 32;
        c.W = in[28] + (size_t)l * PLE * D; c.gain = nullptr; c.WT = (bf16_t*)(wl + O_PP); c.N = D; c.ldk = PLE; c.drow0 = nb * 32; c.k0 = kb * 64; c.n0 = nb * 32; return c; }
    r -= I_PP;
    {
        const int which = r / I_LR; r %= I_LR; const int hb = r / 2, nb = r % 2;
        c.W = in[which == 0 ? 10 : 12] + (size_t)l * 4 * 4096 + hb * 4096; c.gain = nullptr; c.WT = (bf16_t*)(wl + O_LRU) + which * 16384 + hb * 4096; c.N = 64; c.ldk = 64; c.drow0 = nb * 32; c.k0 = 0; c.n0 = nb * 32; return c; }
}
__device__ __forceinline__ void conv_load(const ConvItem& c, int lane, float (&v)[32], float (&g)[32]) {
    const int n = c.n0 + (lane & 31); const bool ok = n < c.N;
#pragma unroll
    for (int i = 0; i < 32; ++i) { const int kk = 2 * i + (lane >> 5); v[i] = ok ? c.W[(size_t)(c.k0 + kk) * c.N + n] : 0.f; g[i] = c.gain ? c.gain[c.k0 + kk] : 1.0f; }
}
__device__ __forceinline__ void conv_finish(const ConvItem& c, int lane, const float (&v)[32], const float (&g)[32], LAS float* scr) {
#pragma unroll
    for (int i = 0; i < 32; ++i) { const int kk = 2 * i + (lane >> 5); scr[kk * 33 + (lane & 31)] = v[i] * g[i]; }
    asm volatile("s_waitcnt lgkmcnt(0)" ::: "memory");
    const int cc = lane & 7;
#pragma unroll
    for (int j = 0; j < 4; ++j) { const int n = (lane >> 3) + 8 * j; const LAS float* s = scr + (8 * cc) * 33 + n;
        u32x4v o; o.x = pk2(s[0 * 33], s[1 * 33]); o.y = pk2(s[2 * 33], s[3 * 33]); o.z = pk2(s[4 * 33], s[5 * 33]); o.w = pk2(s[6 * 33], s[7 * 33]);
        *(u32x4v*)(c.WT + (size_t)(c.drow0 + n) * c.ldk + c.k0 + 8 * cc) = o; }
    asm volatile("s_waitcnt lgkmcnt(0)" ::: "memory");
}
__device__ __forceinline__ void convert_weights(const float* const* in, unsigned char* ws, LAS float* scr, int gw, int ngw, int lane, int it_lo, int it_hi) {
    asm volatile("" : "+v"(lane));
    int it = it_lo + gw;
    if (it >= it_hi) return;
    ConvItem cur = conv_decode(in, ws, it);
    float va[32], ga[32], vb[32], gb[32];
    conv_load(cur, lane, va, ga);
    for (;;) {
        const int nx = it + ngw; const bool more = nx < it_hi;
        ConvItem nxt = cur;
        if (more) { nxt = conv_decode(in, ws, nx); conv_load(nxt, lane, vb, gb); }
        conv_finish(cur, lane, va, ga, scr);
        if (!more) break;
#pragma unroll
        for (int i = 0; i < 32; ++i) { va[i] = vb[i]; ga[i] = gb[i]; }
        cur = nxt; it = nx;
    }
}

__device__ __forceinline__ void rows_bf16_sumsq(const float* h, bf16_t* xn, float* rss, int gw, int ngw, int lane) {
    asm volatile("" : "+v"(lane));
    for (int m0 = gw; m0 < T; m0 += 2 * ngw) {
        const int m1 = (m0 + ngw < T) ? m0 + ngw : m0;
        f32x4 va[4], vb[4];
#pragma unroll
        for (int j = 0; j < 4; ++j) { va[j] = ((const f32x4*)(h + (size_t)m0 * D) + lane)[64 * j]; vb[j] = ((const f32x4*)(h + (size_t)m1 * D) + lane)[64 * j]; }
#pragma unroll
        for (int rr = 0; rr < 2; ++rr) {
            const int m = rr == 0 ? m0 : m1;
            float s = 0.f;
#pragma unroll
            for (int j = 0; j < 4; ++j) { const f32x4 v = rr == 0 ? va[j] : vb[j]; s += (v[0] * v[0] + v[1] * v[1]) + (v[2] * v[2] + v[3] * v[3]); }
            s = wave_sum(s);
            if (rr == 0 || m1 != m0) {
                u32x2v* o8 = (u32x2v*)(xn + (size_t)m * D) + lane;
#pragma unroll
                for (int j = 0; j < 4; ++j) { const f32x4 v = rr == 0 ? va[j] : vb[j]; u32x2v w; w.x = pk2(v[0], v[1]); w.y = pk2(v[2], v[3]); o8[64 * j] = w; }
                if (lane == 0) *(f32x4*)(rss + (size_t)m * 4) = (f32x4){s, 0.f, 0.f, 0.f};
            }
        }
    }
}
__device__ __forceinline__ void norm_rows_bf16(const float* h, const float* g, bf16_t* xn, int gw, int ngw, int lane) {
    asm volatile("" : "+v"(lane));
    f32x4 gv[4];
#pragma unroll
    for (int j = 0; j < 4; ++j) gv[j] = ((const f32x4*)g)[lane + 64 * j];
    for (int m = gw; m < T; m += ngw) {
        const f32x4* xr = (const f32x4*)(h + (size_t)m * D) + lane;
        f32x4 v[4]; float s = 0.f;
#pragma unroll
        for (int j = 0; j < 4; ++j) { v[j] = xr[64 * j]; s += (v[j][0] * v[j][0] + v[j][1] * v[j][1]) + (v[j][2] * v[j][2] + v[j][3] * v[j][3]); }
        const float rstd = 1.0f / sqrtf(wave_sum(s) * (1.0f / D) + EPS);
        u32x2v* o8 = (u32x2v*)(xn + (size_t)m * D) + lane;
#pragma unroll
        for (int j = 0; j < 4; ++j) { u32x2v w; w.x = pk2(v[j][0] * rstd * gv[j][0], v[j][1] * rstd * gv[j][1]); w.y = pk2(v[j][2] * rstd * gv[j][2], v[j][3] * rstd * gv[j][3]); o8[64 * j] = w; }
    }
}
__device__ __forceinline__ void final_norm_rows(const bf16_t* h, const float* g, float* out, int gw, int ngw, int lane) {
    asm volatile("" : "+v"(lane));
    f32x4 gv[4];
#pragma unroll
    for (int j = 0; j < 4; ++j) gv[j] = ((const f32x4*)g)[lane + 64 * j];
    for (int m0 = gw; m0 < T; m0 += 2 * ngw) {
        const int m1 = (m0 + ngw < T) ? m0 + ngw : m0;
        u32x2v w0[4], w1[4];
#pragma unroll
        for (int j = 0; j < 4; ++j) { w0[j] = ((const u32x2v*)(h + (size_t)m0 * D) + lane)[64 * j]; w1[j] = ((const u32x2v*)(h + (size_t)m1 * D) + lane)[64 * j]; }
#pragma unroll
        for (int rr = 0; rr < 2; ++rr) {
            const int m = rr == 0 ? m0 : m1;
            f32x4 v[4]; float s = 0.f;
#pragma unroll
            for (int j = 0; j < 4; ++j) { const u32x2v w = rr == 0 ? w0[j] : w1[j]; v[j][0] = bflo(w.x); v[j][1] = bfhi(w.x); v[j][2] = bflo(w.y); v[j][3] = bfhi(w.y); s += (v[j][0] * v[j][0] + v[j][1] * v[j][1]) + (v[j][2] * v[j][2] + v[j][3] * v[j][3]); }
            const float rstd = 1.0f / sqrtf(wave_sum(s) * (1.0f / D) + EPS);
            f32x4* o = (f32x4*)(out + (size_t)m * D) + lane;
            if (rr == 0 || m1 != m0) {
#pragma unroll
                for (int j = 0; j < 4; ++j) o[64 * j] = v[j] * rstd * gv[j];
            }
        }
    }
}
__device__ __forceinline__ void convert_p(const float* p, bf16_t* pbf, size_t gtid, size_t gthreads) {
    asm volatile("" : "+v"(gtid));
    const size_t n8 = (size_t)T * PLE / 8;
    for (size_t i = gtid; i < n8; i += gthreads) { const f32x4 a = ((const f32x4*)p)[2 * i], b = ((const f32x4*)p)[2 * i + 1];
        u32x4v w; w.x = pk2(a[0], a[1]); w.y = pk2(a[2], a[3]); w.z = pk2(b[0], b[1]); w.w = pk2(b[2], b[3]); ((u32x4v*)pbf)[i] = w; }
}

#define MFMA16(a, b, c) __builtin_amdgcn_mfma_f32_16x16x32_bf16((a), (b), (c), 0, 0, 0)

#define XB_TMO      128
#define XB_XCNT(j)  (256  + 64 * (j))
#define XB_XSUB(j)  (1280 + 64 * (j))
#define XB_XGEN(j)  (2304 + 64 * (j))
#define XB_TOP      3328
#define XB_TOPGEN   3392
#define XCD_BAR_WORDS 3456
#define XB_SPIN_CAP (1u << 18)

__device__ __forceinline__ unsigned xb_ld(unsigned* p)              { return __hip_atomic_load(p, __ATOMIC_RELAXED, __HIP_MEMORY_SCOPE_AGENT); }
__device__ __forceinline__ unsigned xb_add(unsigned* p, unsigned v) { return __hip_atomic_fetch_add(p, v, __ATOMIC_RELAXED, __HIP_MEMORY_SCOPE_AGENT); }
__device__ __forceinline__ unsigned xb_xcc_id() { return (unsigned)__builtin_amdgcn_s_getreg((3 << 11) | 20) & 0xFu; }
#define XB_SPIN(cond, bar) do { unsigned _sp = 0; while (cond) { __builtin_amdgcn_s_sleep(16); \
    if ((++_sp & 255u) == 0u) { if (xb_ld(&(bar)[XB_TMO])) break; if (_sp > XB_SPIN_CAP) { atomicAdd(&(bar)[XB_TMO], 1u); break; } } } } while (0)

struct XcdBarrier {
    unsigned* bar; unsigned x;
    volatile LAS unsigned* st;
};

__device__ __forceinline__ XcdBarrier xcd_barrier_post(unsigned* bar, volatile LAS unsigned* st) {
    XcdBarrier b; b.bar = bar; b.x = xb_xcc_id(); b.st = st;
    if (threadIdx.x == 0) (void)xb_add(&bar[XB_XCNT(b.x)], 1u);
    return b;
}
__device__ __forceinline__ void xcd_barrier_complete(unsigned* bar, unsigned x, unsigned& nloc, unsigned& nx) {
    const unsigned G = gridDim.x * gridDim.y * gridDim.z;
    unsigned sum, cnt, mine, sp = 0u;
    for (;;) {
        sum = 0u; cnt = 0u; mine = 0u;
#pragma unroll
        for (unsigned j = 0; j < 16; ++j) { const unsigned c = xb_ld(&bar[XB_XCNT(j)]); sum += c; cnt += (c > 0u) ? 1u : 0u; mine = (j == x) ? c : mine; }
        if (sum == G) break;
        __builtin_amdgcn_s_sleep(1);
        if ((++sp & 255u) == 0u) { if (xb_ld(&bar[XB_TMO])) break; if (sp > XB_SPIN_CAP) { atomicAdd(&bar[XB_TMO], 1u); break; } }
    }
    nloc = mine > 0u ? mine : 1u; nx = cnt > 0u ? cnt : 1u;
}

__device__ __forceinline__ void xcd_barrier(const XcdBarrier& b) {
    asm volatile("s_waitcnt vmcnt(0)" ::: "memory");
    __syncthreads();
    if (threadIdx.x == 0) {
        unsigned* bar = b.bar;
        __builtin_amdgcn_s_waitcnt(0);
        unsigned nloc = b.st[0], nx = b.st[1];
        if (nloc == 0u) { xcd_barrier_complete(bar, b.x, nloc, nx); b.st[0] = nloc; b.st[1] = nx; }
        const unsigned old = xb_add(&bar[XB_XSUB(b.x)], 1u);
        const unsigned gen = old / nloc;
        if (old + 1u == (gen + 1u) * nloc) {
            __builtin_amdgcn_fence(__ATOMIC_RELEASE, "agent");
            asm volatile("s_waitcnt vmcnt(0)" ::: "memory");
            const unsigned og = xb_add(&bar[XB_TOP], 1u);
            const unsigned tg = og / nx;
            if (og + 1u == (tg + 1u) * nx) xb_add(&bar[XB_TOPGEN], 1u);
            else XB_SPIN(xb_ld(&bar[XB_TOPGEN]) == tg, bar);
            __builtin_amdgcn_fence(__ATOMIC_ACQUIRE, "agent");
            xb_add(&bar[XB_XGEN(b.x)], 1u);
            asm volatile("s_waitcnt vmcnt(0)" ::: "memory");
        } else {
            XB_SPIN(xb_ld(&bar[XB_XGEN(b.x)]) == gen, bar);
            __builtin_amdgcn_fence(__ATOMIC_ACQUIRE, "agent");
            asm volatile("s_waitcnt vmcnt(0)" ::: "memory");
        }
    }
    __syncthreads();
}


__device__ __forceinline__ void mixer_pre_item(int item, const float* const* in, int l, unsigned char* ws, LAS unsigned char* lds, int tid, int lane, int wave) {
    asm volatile("" : "+v"(tid)); lane = tid & 63; wave = __builtin_amdgcn_readfirstlane(tid >> 6);
    const int b = item >> 6, c = item & 63, s0 = c * 32;
    const size_t g0 = (size_t)b * SEQ + s0;
    const bf16_t* U = (const bf16_t*)(ws + WS_R1);
    LAS bf16_t* STGL = (LAS bf16_t*)lds;
    LAS bf16_t* STGD = (LAS bf16_t*)(lds + 17920);
    LAS float* XRF = (LAS float*)(lds + 17920);
    LAS float* AF = (LAS float*)(lds + 50688);
    LAS bf16_t* XRB = (LAS bf16_t*)(lds + 83456);
    __syncthreads();
#pragma unroll
    for (int i = 0; i < 9; ++i) { const int id = tid + 512 * i;
        if (id < 35 * 128) { const int row = id >> 7, pc = id & 127, s = s0 - 3 + row;
            u32x4v v = (u32x4v){0u, 0u, 0u, 0u};
            if (s >= 0) v = *(const u32x4v*)(U + ((size_t)b * SEQ + s) * NIN + (pc < 32 ? pc * 8 : U_DQ + (pc - 32) * 8));
            if (pc < 32) *(LAS u32x4v*)(STGL + row * 256 + pc * 8) = v; else *(LAS u32x4v*)(STGD + row * 768 + (pc - 32) * 8) = v; } }
    __syncthreads();
    for (int task = wave; task < 24; task += 8) {
        const int g = task >> 1, t0 = (task & 1) * 16, kind = g >> 2, hh = g & 3, cc = g * 64 + lane;
        const float* cw = in[17] + (size_t)l * 4 * 768;
        const float w0 = cw[cc], w1 = cw[768 + cc], w2 = cw[1536 + cc], w3 = cw[2304 + cc];
        bf16_t* dst = (bf16_t*)(ws + WS_R2 + (kind == 0 ? R2_DQ : kind == 1 ? R2_DK : R2_DV)) + (g0 + t0) * 256 + hh * 64 + lane;
        float xm3 = bf2f(STGD[t0 * 768 + cc]), xm2 = bf2f(STGD[(t0 + 1) * 768 + cc]), xm1 = bf2f(STGD[(t0 + 2) * 768 + cc]);
        const float qs = (kind == 0) ? 0.125f : 1.0f;
#pragma unroll 8
        for (int t = 0; t < 16; ++t) { const float xc = bf2f(STGD[(t0 + t + 3) * 768 + cc]); float y = siluf_(w0 * xm3 + w1 * xm2 + w2 * xm1 + w3 * xc);
            if (kind < 2) { const float ss = wave_sum(y * y); y *= qs * __builtin_amdgcn_rsqf(ss + EPS); }
            dst[(size_t)t * 256] = f2bf(y);
            xm3 = xm2; xm2 = xm1; xm1 = xc; }
    }
    if (tid < 128) { const int tok = tid >> 2, hh = tid & 3; const float* sd = (const float*)(ws + WS_R2 + R2_DNBA) + (g0 + tok) * 8;
        const float beta = sigmoidf_(sd[hh]), g = -__expf(in[18][l * 4 + hh]) * softplusf_(sd[4 + hh] + in[19][l * 4 + hh]);
        ((float*)(ws + WS_R2 + R2_GG))[(g0 + tok) * 4 + hh] = g; ((float*)(ws + WS_R2 + R2_BE))[(g0 + tok) * 4 + hh] = beta; }
    __syncthreads();
    {
        const int ch = tid & 255, t0 = (tid >> 8) * 16;
        const float* cw = in[8] + (size_t)l * 4 * 256;
        const float w0 = cw[ch], w1 = cw[256 + ch], w2 = cw[512 + ch], w3 = cw[768 + ch], bb = in[9][l * 256 + ch];
        float xm3 = bf2f(STGL[t0 * 256 + ch]), xm2 = bf2f(STGL[(t0 + 1) * 256 + ch]), xm1 = bf2f(STGL[(t0 + 2) * 256 + ch]);
#pragma unroll 8
        for (int i = 0; i < 16; ++i) { const float xc = bf2f(STGL[(t0 + i + 3) * 256 + ch]); const float xr = w0 * xm3 + w1 * xm2 + w2 * xm1 + w3 * xc + bb;
            XRF[(t0 + i) * 256 + ch] = xr; XRB[(t0 + i) * 264 + ch] = f2bf(xr); xm3 = xm2; xm2 = xm1; xm1 = xc; }
    }
    __syncthreads();
    {
        const int hb = wave & 3, mf = wave >> 2, fr = lane & 15, q = lane >> 4;
        const bf16_t* WTa = (const bf16_t*)(ws + WS_W + (size_t)l * W_LAYER + O_LRU) + hb * 4096;
        const bf16_t* WTx = WTa + 16384;
        f32x4 aa[4], ax[4];
#pragma unroll
        for (int nf = 0; nf < 4; ++nf) { aa[nf] = (f32x4){0.f, 0.f, 0.f, 0.f}; ax[nf] = (f32x4){0.f, 0.f, 0.f, 0.f}; }
#pragma unroll
        for (int ks = 0; ks < 2; ++ks) {
            const bf16x8 A = *(const LAS bf16x8*)(XRB + (16 * mf + fr) * 264 + 64 * hb + 32 * ks + 8 * q);
#pragma unroll
            for (int nf = 0; nf < 4; ++nf) {
                const bf16x8 Ba = *(const bf16x8*)(WTa + (16 * nf + fr) * 64 + 32 * ks + 8 * q), Bx = *(const bf16x8*)(WTx + (16 * nf + fr) * 64 + 32 * ks + 8 * q);
                aa[nf] = MFMA16(A, Ba, aa[nf]); ax[nf] = MFMA16(A, Bx, ax[nf]); }
        }
#pragma unroll
        for (int nf = 0; nf < 4; ++nf) {
            const int ch = 64 * hb + 16 * nf + fr;
            const float ba = in[11][l * 256 + ch], bx = in[13][l * 256 + ch], sp = softplusf_(-in[14][l * 256 + ch]);
#pragma unroll
            for (int jj = 0; jj < 4; ++jj) { const int tok = 16 * mf + 4 * q + jj;
                const float r = sigmoidf_(aa[nf][jj] + ba), ig = sigmoidf_(ax[nf][jj] + bx), la = -8.0f * r * sp, a = __expf(la), x2 = 2.0f * la;
                const float om = (x2 > -0.25f) ? -x2 * (1.0f + x2 * (0.5f + x2 * (0.16666667f + x2 * (0.041666668f + x2 * (0.008333334f + x2 * 0.0013888889f))))) : 1.0f - a * a;
                const float mult = sqrtf(om);
                const float xr = XRF[tok * 256 + ch]; AF[tok * 256 + ch] = a; XRF[tok * 256 + ch] = mult * ig * xr; }
        }
    }
    __syncthreads();
    if (tid < 256) {
        float h = 0.f, P = 1.f;
        bf16_t* LH = (bf16_t*)(ws + WS_R2 + R2_LH) + g0 * 256 + tid; bf16_t* PC = (bf16_t*)(ws + WS_R2 + R2_PC) + g0 * 256 + tid;
#pragma unroll 8
        for (int t = 0; t < 32; ++t) { const float a = AF[t * 256 + tid], uu = XRF[t * 256 + tid]; h = a * h + uu; P *= a; LH[t * 256] = f2bf(h); PC[t * 256] = f2bf(P); }
        float2 ag; ag.x = P; ag.y = h; ((float2*)(ws + WS_R2 + R2_AGG))[(size_t)(b * 64 + c) * 256 + tid] = ag;
    }
}

__device__ __forceinline__ void dn_prep_item(int item, unsigned char* ws, LAS unsigned char* lds, int tid, int lane, int wave) {
    asm volatile("" : "+v"(tid)); lane = tid & 63; wave = __builtin_amdgcn_readfirstlane(tid >> 6);
    const int b = item >> 5, c = item & 31;
    const size_t tok0 = (size_t)b * SEQ + c * 64;
    LAS float* LM = (LAS float*)lds;
    LAS float* GC = (LAS float*)(lds + 65536);
    LAS float* BES = (LAS float*)(lds + 65536 + 2048);
    const bf16_t* DQ = (const bf16_t*)(ws + WS_R2 + R2_DQ); const bf16_t* DK = (const bf16_t*)(ws + WS_R2 + R2_DK);
    const bf16_t* DV = (const bf16_t*)(ws + WS_R2 + R2_DV); bf16_t* UUo = (bf16_t*)(ws + WS_UU);
    bf16_t* WW = (bf16_t*)(ws + WS_R2 + R2_WW); bf16_t* QG = (bf16_t*)(ws + WS_R2 + R2_QG); bf16_t* ATT = (bf16_t*)(ws + WS_R2 + R2_ATT); bf16_t* KDT = (bf16_t*)(ws + WS_R2 + R2_KDT);
    const int hd = wave >> 1, half = wave & 1, fr = lane & 15, q = lane >> 4;
    __syncthreads();
    float gc = ((const float*)(ws + WS_R2 + R2_GG))[(tok0 + lane) * 4 + hd];
    const float be_l = ((const float*)(ws + WS_R2 + R2_BE))[(tok0 + lane) * 4 + hd];
    bf16x8 Bk[4][2], Aq[2][2];
#pragma unroll
    for (int cf = 0; cf < 4; ++cf)
#pragma unroll
        for (int ks = 0; ks < 2; ++ks) Bk[cf][ks] = *(const bf16x8*)(DK + (tok0 + 16 * cf + fr) * 256 + hd * 64 + 32 * ks + 8 * q);
    bf16x8 Ak[2][2], Kd[4];
#pragma unroll
    for (int r2 = 0; r2 < 2; ++r2)
#pragma unroll
        for (int ks = 0; ks < 2; ++ks) { Aq[r2][ks] = *(const bf16x8*)(DQ + (tok0 + 16 * (2 * half + r2) + fr) * 256 + hd * 64 + 32 * ks + 8 * q); Ak[r2][ks] = *(const bf16x8*)(DK + (tok0 + 16 * (2 * half + r2) + fr) * 256 + hd * 64 + 32 * ks + 8 * q); }
#pragma unroll
    for (int cf = 0; cf < 4; ++cf) Kd[cf] = *(const bf16x8*)(DK + (tok0 + 16 * cf + fr) * 256 + hd * 64 + 32 * half + 8 * q);
    {
#pragma unroll
        for (int o = 1; o < 64; o <<= 1) { const float t = __shfl_up(gc, o); if (lane >= o) gc += t; }
        const float glast = __shfl(gc, 63);
        GC[wave * 64 + lane] = gc; BES[wave * 64 + lane] = be_l;
        if (half == 0 && lane == 0) ((float*)(ws + WS_R2 + R2_EGL))[(size_t)(b * 32 + c) * 4 + hd] = __expf(glast);
        asm volatile("s_waitcnt lgkmcnt(0)" ::: "memory");
        float gjv[4], giv[2][4], biv[2][4];
#pragma unroll
        for (int cf = 0; cf < 4; ++cf) gjv[cf] = GC[wave * 64 + 16 * cf + fr];
#pragma unroll
        for (int r2 = 0; r2 < 2; ++r2)
#pragma unroll
            for (int jj = 0; jj < 4; ++jj) { const int i = 16 * (2 * half + r2) + 4 * q + jj; giv[r2][jj] = GC[wave * 64 + i]; biv[r2][jj] = BES[wave * 64 + i]; }
        const float sc_q0 = __expf(GC[wave * 64 + 16 * (2 * half) + fr]), sc_q1 = __expf(GC[wave * 64 + 16 * (2 * half + 1) + fr]);
#pragma unroll
        for (int r2 = 0; r2 < 2; ++r2) { const int rf = 2 * half + r2;
#pragma unroll
            for (int cf = 0; cf < 4; ++cf) {
                f32x4 kk = (f32x4){0.f, 0.f, 0.f, 0.f}, qk = (f32x4){0.f, 0.f, 0.f, 0.f};
#pragma unroll
                for (int ks = 0; ks < 2; ++ks) { kk = MFMA16(Ak[r2][ks], Bk[cf][ks], kk); qk = MFMA16(Aq[r2][ks], Bk[cf][ks], qk); }
                const int j = 16 * cf + fr; const float gj = gjv[cf];
#pragma unroll
                for (int jj = 0; jj < 4; ++jj) { const int i = 16 * rf + 4 * q + jj; const float gi = giv[r2][jj], bi = biv[r2][jj];
                    const float dec = (j <= i) ? __expf(gi - gj) : 0.f;
                    LM[(hd * 64 + i) * 64 + j] = (j < i) ? bi * kk[jj] * dec : 0.f;
                    ATT[(tok0 + i) * 256 + hd * 64 + j] = f2bf(qk[jj] * dec); }
            }
        }
#pragma unroll
        for (int r2 = 0; r2 < 2; ++r2) { const int iq = 16 * (2 * half + r2) + fr; const float sc = r2 == 0 ? sc_q0 : sc_q1;
#pragma unroll
            for (int ks = 0; ks < 2; ++ks) { const u32x4v w = __builtin_bit_cast(u32x4v, Aq[r2][ks]);
                u32x4v r; r.x = pk2(bflo(w.x) * sc, bfhi(w.x) * sc); r.y = pk2(bflo(w.y) * sc, bfhi(w.y) * sc); r.z = pk2(bflo(w.z) * sc, bfhi(w.z) * sc); r.w = pk2(bflo(w.w) * sc, bfhi(w.w) * sc);
                *(u32x4v*)(QG + (tok0 + iq) * 256 + hd * 64 + 32 * ks + 8 * q) = r; } }
#pragma unroll
        for (int cf = 0; cf < 4; ++cf) { const int cj = 16 * cf + fr; const float sc = __expf(glast - gjv[cf]);
            const u32x4v w = __builtin_bit_cast(u32x4v, Kd[cf]);
            bf16_t* dp = KDT + (tok0 + 32 * half + 8 * q) * 256 + hd * 64 + cj;
            dp[0 * 256] = f2bf(bflo(w.x) * sc); dp[1 * 256] = f2bf(bfhi(w.x) * sc); dp[2 * 256] = f2bf(bflo(w.y) * sc); dp[3 * 256] = f2bf(bfhi(w.y) * sc);
            dp[4 * 256] = f2bf(bflo(w.z) * sc); dp[5 * 256] = f2bf(bfhi(w.z) * sc); dp[6 * 256] = f2bf(bflo(w.w) * sc); dp[7 * 256] = f2bf(bfhi(w.w) * sc); }
    }
    unsigned short xr[64];
    { const bf16_t* src = (half == 0 ? DV : DK) + tok0 * 256 + hd * 64 + lane;
#pragma unroll
      for (int i = 0; i < 64; ++i) xr[i] = src[(size_t)i * 256]; }
    __syncthreads();
    {
        const int col = lane;
        float x[64];
#ifdef PROBE_PHB
        for (int rep_ = 0; rep_ < PROBE_PHB; ++rep_) { asm volatile("" ::: "memory");
#endif
        const LAS float* bes = BES + (hd * 2) * 64; const LAS float* gcs = GC + (hd * 2) * 64;
        if (half == 0) {
#pragma unroll
            for (int i = 0; i < 64; ++i) x[i] = bf2f(xr[i]) * bes[i];
        } else {
#pragma unroll
            for (int i = 0; i < 64; ++i) x[i] = bf2f(xr[i]) * bes[i] * __expf(gcs[i]);
        }
        const LAS float* Lh = LM + hd * 4096;
#pragma unroll
        for (int i = 1; i < 64; ++i) {
            float acc = x[i];
#pragma unroll
            for (int j4 = 0; j4 < (i + 3) / 4; ++j4) { const f32x4 lv = *(const LAS f32x4*)(Lh + i * 64 + 4 * j4);
#pragma unroll
                for (int jj = 0; jj < 4; ++jj) if (4 * j4 + jj < i) acc -= lv[jj] * x[4 * j4 + jj]; }
            x[i] = acc;
        }
#ifdef PROBE_PHB
        asm volatile("" : "+v"(x[63])); }
#endif
        if (half == 0) {
#pragma unroll
            for (int i = 0; i < 64; ++i) UUo[(tok0 + i) * 256 + hd * 64 + col] = f2bf(x[i]);
        } else {
#pragma unroll
            for (int i = 0; i < 64; ++i) WW[(tok0 + i) * 256 + hd * 64 + col] = f2bf(x[i]);
        }
    }
}
__device__ __forceinline__ void dn_chain_item(int item, const float* const* in, int l, unsigned char* ws, bf16_t* ybuf, LAS unsigned char* lds, int tid, int lane, int wave) {
    asm volatile("" : "+v"(tid)); lane = tid & 63; wave = __builtin_amdgcn_readfirstlane(tid >> 6);
    const int b = item >> 2, hd = item & 3;
    LAS bf16_t* Wl = (LAS bf16_t*)lds; LAS bf16_t* QGl = Wl + 64 * 72; LAS bf16_t* ATl = QGl + 64 * 72; LAS bf16_t* KDl = ATl + 64 * 72;
    LAS bf16_t* UUl = (LAS bf16_t*)(lds + 36864); LAS float* OSl = (LAS float*)(lds + 53248);
    const bf16_t* WW = (const bf16_t*)(ws + WS_R2 + R2_WW); const bf16_t* QG = (const bf16_t*)(ws + WS_R2 + R2_QG); const bf16_t* ATT = (const bf16_t*)(ws + WS_R2 + R2_ATT); const bf16_t* KDT = (const bf16_t*)(ws + WS_R2 + R2_KDT);
    const bf16_t* UUg = (const bf16_t*)(ws + WS_UU); const float* EGL = (const float*)(ws + WS_R2 + R2_EGL);
    const bf16_t* U = (const bf16_t*)(ws + WS_R1); bf16_t* Y = ybuf;
    const int lr = tid >> 3, lp = tid & 7, fr = lane & 15, q = lane >> 4, ef = wave;
    const int orow = (tid & 255) >> 2, op = tid & 3;
    const size_t base = (size_t)b * SEQ * 256 + hd * 64;
    f32x4 Sacc[4];
#pragma unroll
    for (int df = 0; df < 4; ++df) Sacc[df] = (f32x4){0.f, 0.f, 0.f, 0.f};
    u32x4v rwA, rqA, raA, rkA, ruA, rz0A, rz1A, rwB, rqB, raB, rkB, ruB, rz0B, rz1B, pz0, pz1;
    rz0A = (u32x4v){0u, 0u, 0u, 0u}; rz1A = rz0A; rz0B = rz0A; rz1B = rz0A;
    pz0 = (u32x4v){0u, 0u, 0u, 0u}; pz1 = pz0;
#define DN_LOAD(cc, S) do { const size_t o = base + (size_t)((cc) * 64 + lr) * 256 + lp * 8; rw##S = *(const u32x4v*)(WW + o); rq##S = *(const u32x4v*)(QG + o); ra##S = *(const u32x4v*)(ATT + o); rk##S = *(const u32x4v*)(KDT + o); \
        ru##S = *(const u32x4v*)(UUg + o); \
        if (wave >= 4) { const bf16_t* zp = U + ((size_t)b * SEQ + (cc) * 64 + orow) * NIN + U_DZ + hd * 64 + op * 16; rz0##S = *(const u32x4v*)zp; rz1##S = *(const u32x4v*)(zp + 8); } } while (0)
#define DN_OUT(cc, zA, zB) do { const LAS float* os = OSl + ((cc) & 1) * 4096 + orow * 64 + op * 16; const f32x4 o0 = *(const LAS f32x4*)os, o1 = *(const LAS f32x4*)(os + 4), o2 = *(const LAS f32x4*)(os + 8), o3 = *(const LAS f32x4*)(os + 12); \
        float ss = (o0[0] * o0[0] + o0[1] * o0[1]) + (o0[2] * o0[2] + o0[3] * o0[3]) + (o1[0] * o1[0] + o1[1] * o1[1]) + (o1[2] * o1[2] + o1[3] * o1[3]) + (o2[0] * o2[0] + o2[1] * o2[1]) + (o2[2] * o2[2] + o2[3] * o2[3]) + (o3[0] * o3[0] + o3[1] * o3[1]) + (o3[2] * o3[2] + o3[3] * o3[3]); \
        ss += __shfl_xor(ss, 1); ss += __shfl_xor(ss, 2); \
        const float rs = 1.0f / sqrtf(ss * (1.0f / 64.0f) + EPS); \
        const f32x4 n0 = nwA * rs, n1 = nwB * rs, n2 = nwC * rs, n3 = nwD * rs; \
        u32x4v w0, w1; \
        w0.x = pk2(o0[0] * n0[0] * siluf_(bflo(zA.x)), o0[1] * n0[1] * siluf_(bfhi(zA.x))); w0.y = pk2(o0[2] * n0[2] * siluf_(bflo(zA.y)), o0[3] * n0[3] * siluf_(bfhi(zA.y))); \
        w0.z = pk2(o1[0] * n1[0] * siluf_(bflo(zA.z)), o1[1] * n1[1] * siluf_(bfhi(zA.z))); w0.w = pk2(o1[2] * n1[2] * siluf_(bflo(zA.w)), o1[3] * n1[3] * siluf_(bfhi(zA.w))); \
        w1.x = pk2(o2[0] * n2[0] * siluf_(bflo(zB.x)), o2[1] * n2[1] * siluf_(bfhi(zB.x))); w1.y = pk2(o2[2] * n2[2] * siluf_(bflo(zB.y)), o2[3] * n2[3] * siluf_(bfhi(zB.y))); \
        w1.z = pk2(o3[0] * n3[0] * siluf_(bflo(zB.z)), o3[1] * n3[1] * siluf_(bfhi(zB.z))); w1.w = pk2(o3[2] * n3[2] * siluf_(bflo(zB.w)), o3[3] * n3[3] * siluf_(bfhi(zB.w))); \
        bf16_t* yp = Y + ((size_t)b * SEQ + (cc) * 64 + orow) * D + 768 + hd * 64 + op * 16; *(u32x4v*)yp = w0; *(u32x4v*)(yp + 8) = w1; } while (0)
    const float* nwp = in[20] + l * 64 + op * 16; const f32x4 nwA = *(const f32x4*)nwp, nwB = *(const f32x4*)(nwp + 4), nwC = *(const f32x4*)(nwp + 8), nwD = *(const f32x4*)(nwp + 12);
#define DN_FRAG(P, row, s) ({ const LAS bf16_t* _p = (P) + (row) * 72 + 32 * (s) + 4 * q; const u32x2v _lo = *(const LAS u32x2v*)_p, _hi = *(const LAS u32x2v*)(_p + 16); u32x4v _w; _w.x = _lo.x; _w.y = _lo.y; _w.z = _hi.x; _w.w = _hi.y; __builtin_bit_cast(bf16x8, _w); })
#define DN_BODY(c, S) do { \
        *(LAS u32x4v*)(Wl + lr * 72 + lp * 8) = rw##S; *(LAS u32x4v*)(QGl + lr * 72 + lp * 8) = rq##S; *(LAS u32x4v*)(ATl + lr * 72 + lp * 8) = ra##S; *(LAS u32x4v*)(KDl + lr * 72 + lp * 8) = rk##S; \
        *(LAS u32x4v*)(UUl + lr * 72 + lp * 8) = ru##S; \
        const u32x4v cz0 = pz0, cz1 = pz1; \
        pz0 = rz0##S; pz1 = rz1##S; \
        const float egl = egl_n; egl_n = EGL[(size_t)(b * 32 + (c + 1 < 32 ? c + 1 : c)) * 4 + hd]; \
        __syncthreads(); \
        if (c + 2 < 32) DN_LOAD(c + 2, S); \
        if (wave < 4) { \
            LAS float* OSc = OSl + (c & 1) * 4096; \
            bf16x8 fr_[4][2]; float uu[4][4]; \
            bf16x8 Sb[2], Vb[2]; \
_Pragma("unroll") \
            for (int s = 0; s < 2; ++s) { u32x4v w; w.x = pk2(Sacc[2 * s][0], Sacc[2 * s][1]); w.y = pk2(Sacc[2 * s][2], Sacc[2 * s][3]); w.z = pk2(Sacc[2 * s + 1][0], Sacc[2 * s + 1][1]); w.w = pk2(Sacc[2 * s + 1][2], Sacc[2 * s + 1][3]); Sb[s] = __builtin_bit_cast(bf16x8, w); } \
            f32x4 vn[4], oo[4]; \
_Pragma("unroll") \
            for (int cf = 0; cf < 4; ++cf) \
_Pragma("unroll") \
                for (int s = 0; s < 2; ++s) fr_[cf][s] = DN_FRAG(Wl, 16 * cf + fr, s); \
_Pragma("unroll") \
            for (int cf = 0; cf < 4; ++cf) \
_Pragma("unroll") \
                for (int jj = 0; jj < 4; ++jj) uu[cf][jj] = bf2f(UUl[(16 * cf + 4 * q + jj) * 72 + 16 * ef + fr]); \
_Pragma("unroll") \
            for (int cf = 0; cf < 4; ++cf) { f32x4 a = (f32x4){0.f, 0.f, 0.f, 0.f}; a = MFMA16(fr_[cf][0], Sb[0], a); a = MFMA16(fr_[cf][1], Sb[1], a); vn[cf] = a; } \
_Pragma("unroll") \
            for (int cf = 0; cf < 4; ++cf) \
_Pragma("unroll") \
                for (int s = 0; s < 2; ++s) fr_[cf][s] = DN_FRAG(QGl, 16 * cf + fr, s); \
_Pragma("unroll") \
            for (int cf = 0; cf < 4; ++cf) { f32x4 a = (f32x4){0.f, 0.f, 0.f, 0.f}; a = MFMA16(fr_[cf][0], Sb[0], a); a = MFMA16(fr_[cf][1], Sb[1], a); oo[cf] = a; } \
_Pragma("unroll") \
            for (int cf = 0; cf < 4; ++cf) \
_Pragma("unroll") \
                for (int s = 0; s < 2; ++s) if (32 * s <= 16 * cf + 15) fr_[cf][s] = DN_FRAG(ATl, 16 * cf + fr, s); \
_Pragma("unroll") \
            for (int cf = 0; cf < 4; ++cf) \
_Pragma("unroll") \
                for (int jj = 0; jj < 4; ++jj) vn[cf][jj] = uu[cf][jj] - vn[cf][jj]; \
_Pragma("unroll") \
            for (int s = 0; s < 2; ++s) { u32x4v w; w.x = pk2(vn[2 * s][0], vn[2 * s][1]); w.y = pk2(vn[2 * s][2], vn[2 * s][3]); w.z = pk2(vn[2 * s + 1][0], vn[2 * s + 1][1]); w.w = pk2(vn[2 * s + 1][2], vn[2 * s + 1][3]); Vb[s] = __builtin_bit_cast(bf16x8, w); } \
_Pragma("unroll") \
            for (int cf = 0; cf < 4; ++cf) \
_Pragma("unroll") \
                for (int s = 0; s < 2; ++s) if (32 * s <= 16 * cf + 15) oo[cf] = MFMA16(fr_[cf][s], Vb[s], oo[cf]); \
_Pragma("unroll") \
            for (int cf = 0; cf < 4; ++cf) \
_Pragma("unroll") \
                for (int s = 0; s < 2; ++s) fr_[cf][s] = DN_FRAG(KDl, 16 * cf + fr, s); \
_Pragma("unroll") \
            for (int df = 0; df < 4; ++df) { f32x4 a = Sacc[df] * egl; a = MFMA16(fr_[df][0], Vb[0], a); a = MFMA16(fr_[df][1], Vb[1], a); Sacc[df] = a; } \
_Pragma("unroll") \
            for (int cf = 0; cf < 4; ++cf) \
_Pragma("unroll") \
                for (int jj = 0; jj < 4; ++jj) OSc[(16 * cf + 4 * q + jj) * 64 + 16 * ef + fr] = oo[cf][jj]; \
        } else if (c > 0) { DN_OUT(c - 1, cz0, cz1); } \
        __syncthreads(); \
    } while (0)
    DN_LOAD(0, A); DN_LOAD(1, B);
    float egl_n = EGL[(size_t)(b * 32) * 4 + hd];
    __syncthreads();
    for (int c2 = 0; c2 < 32; c2 += 2) { DN_BODY(c2, A); DN_BODY(c2 + 1, B); }
    if (wave >= 4) { DN_OUT(31, pz0, pz1); }
    __syncthreads();
#undef DN_LOAD
#undef DN_BODY
#undef DN_OUT
#undef DN_FRAG
}
__device__ __forceinline__ void lru_carry_item(int b, unsigned char* ws, int tid) {
    asm volatile("" : "+v"(tid));
    if (tid < 256) {
        const float2* AGG = (const float2*)(ws + WS_R2 + R2_AGG) + (size_t)b * 64 * 256 + tid;
        float* CARRY = (float*)(ws + WS_R2 + R2_CARRY) + (size_t)b * 64 * 256 + tid;
        float carry = 0.f;
#pragma unroll
        for (int h = 0; h < 2; ++h) {
            float2 ag[32];
#pragma unroll
            for (int k = 0; k < 32; ++k) ag[k] = AGG[(h * 32 + k) * 256];
#pragma unroll
            for (int k = 0; k < 32; ++k) { CARRY[(h * 32 + k) * 256] = carry; carry = ag[k].x * carry + ag[k].y; }
        }
    }
}
__device__ __forceinline__ void lru_fix_item(int item, unsigned char* ws, bf16_t* ybuf, int tid) {
    asm volatile("" : "+v"(tid));
    const int b = item >> 6, c = item & 63, cv = (tid & 31) * 8;
    const float* cp = (const float*)(ws + WS_R2 + R2_CARRY) + (size_t)(b * 64 + c) * 256 + cv;
    const f32x4 ca = *(const f32x4*)cp, cb = *(const f32x4*)(cp + 4);
    u32x4v lh[2], pc[2], gt_[2];
#pragma unroll
    for (int j = 0; j < 2; ++j) { const size_t gt = (size_t)b * SEQ + c * 32 + (tid >> 5) + 16 * j;
        lh[j] = *(const u32x4v*)((const bf16_t*)(ws + WS_R2 + R2_LH) + gt * 256 + cv); pc[j] = *(const u32x4v*)((const bf16_t*)(ws + WS_R2 + R2_PC) + gt * 256 + cv);
        gt_[j] = *(const u32x4v*)((const bf16_t*)(ws + WS_R1) + gt * NIN + U_LRUG + cv); }
#pragma unroll
    for (int j = 0; j < 2; ++j) { const size_t gt = (size_t)b * SEQ + c * 32 + (tid >> 5) + 16 * j;
        u32x4v o;
        o.x = pk2(gelu_tanh(bflo(gt_[j].x)) * (bflo(lh[j].x) + bflo(pc[j].x) * ca[0]), gelu_tanh(bfhi(gt_[j].x)) * (bfhi(lh[j].x) + bfhi(pc[j].x) * ca[1]));
        o.y = pk2(gelu_tanh(bflo(gt_[j].y)) * (bflo(lh[j].y) + bflo(pc[j].y) * ca[2]), gelu_tanh(bfhi(gt_[j].y)) * (bfhi(lh[j].y) + bfhi(pc[j].y) * ca[3]));
        o.z = pk2(gelu_tanh(bflo(gt_[j].z)) * (bflo(lh[j].z) + bflo(pc[j].z) * cb[0]), gelu_tanh(bfhi(gt_[j].z)) * (bfhi(lh[j].z) + bfhi(pc[j].z) * cb[1]));
        o.w = pk2(gelu_tanh(bflo(gt_[j].w)) * (bflo(lh[j].w) + bflo(pc[j].w) * cb[2]), gelu_tanh(bfhi(gt_[j].w)) * (bfhi(lh[j].w) + bfhi(pc[j].w) * cb[3]));
        *(u32x4v*)(ybuf + gt * D + cv) = o; }
}
constexpr int ATT_BT_OFF = 102400;
constexpr int ATT_CT_OFF = 73728;
__device__ __forceinline__ void attn_item(int item, const float* const* in, int l, unsigned char* ws, bf16_t* ybuf, LAS unsigned char* lds, int tid, int lane, int wave) {
    asm volatile("" : "+v"(tid)); lane = tid & 63; wave = __builtin_amdgcn_readfirstlane(tid >> 6);
    const int kh = item & 1, nb = (item >> 1) & 15, b = item >> 5;
    LAS bf16_t* KL = (LAS bf16_t*)lds;
    LAS bf16_t* VT = (LAS bf16_t*)(lds + 36864);
    const LAS float* BT = (const LAS float*)(lds + ATT_BT_OFF);
    LAS float* CT = (LAS float*)(lds + ATT_CT_OFF);
    const bf16_t* U = (const bf16_t*)(ws + WS_R1);
    bf16_t* Y = ybuf;
    const int hl = wave >> 1, hq = kh * 4 + hl, qhalf = wave & 1, fr = lane & 15, q = lane >> 4;
    bf16x8 Bq[4][2];
#pragma unroll
    for (int qg = 0; qg < 4; ++qg) { const bf16_t* qp = U + ((size_t)b * SEQ + nb * 128 + qhalf * 64 + qg * 16 + fr) * NIN + U_AQ + hq * 64 + 8 * q; Bq[qg][0] = *(const bf16x8*)qp; Bq[qg][1] = *(const bf16x8*)(qp + 32); }
    __syncthreads();
#pragma unroll
    for (int i = 0; i < 4; ++i) { const int key = tid & 255, part = (tid >> 8) + 2 * i, pos = (nb - 1) * 128 + key;
        u32x4v kv = (u32x4v){0u, 0u, 0u, 0u}, vv = (u32x4v){0u, 0u, 0u, 0u};
        if (pos >= 0) { const bf16_t* src = U + ((size_t)b * SEQ + pos) * NIN; kv = *(const u32x4v*)(src + 1024 + kh * 64 + part * 8); vv = *(const u32x4v*)(src + 1152 + kh * 64 + part * 8); }
        *(LAS u32x4v*)(KL + key * 72 + part * 8) = kv;
        LAS bf16_t* vd = VT + (part * 8) * 272 + key;
        vd[0] = (bf16_t)(vv.x & 0xffffu); vd[272] = (bf16_t)(vv.x >> 16); vd[2 * 272] = (bf16_t)(vv.y & 0xffffu); vd[3 * 272] = (bf16_t)(vv.y >> 16);
        vd[4 * 272] = (bf16_t)(vv.z & 0xffffu); vd[5 * 272] = (bf16_t)(vv.z >> 16); vd[6 * 272] = (bf16_t)(vv.w & 0xffffu); vd[7 * 272] = (bf16_t)(vv.w >> 16); }
    const float NEG_INF = -__builtin_inff();
    for (int e = tid; e < 4 * 4 * 384; e += NTHR) { const int h = e / 1536, r = e % 1536, sft = r / 384, x = (r % 384) - 128 + sft;
        CT[e] = (x >= 0 && x <= 127) ? BT[(kh * 4 + h) * 128 + (127 - x)] : NEG_INF; }
    __syncthreads();
    const float sink = in[15][l * 8 + hq];
#pragma unroll
    for (int qg = 0; qg < 4; ++qg) {
        const int i0 = qhalf * 64 + qg * 16, iq = i0 + fr, s_lo = 2 * qhalf + (qg >> 1);
        const size_t gt = (size_t)b * SEQ + nb * 128 + iq;
        const bf16x8 Bq0 = Bq[qg][0], Bq1 = Bq[qg][1];
        f32x4 acc[10];
#pragma unroll
        for (int r = 0; r < 10; ++r) { const LAS bf16_t* kp = KL + (16 * (2 * s_lo + r) + fr) * 72 + 8 * q;
            f32x4 a = (f32x4){0.f, 0.f, 0.f, 0.f}; a = MFMA16(*(const LAS bf16x8*)kp, Bq0, a); a = MFMA16(*(const LAS bf16x8*)(kp + 32), Bq1, a); acc[r] = a; }
        const int a1 = iq + 1, sft = (4 - (a1 & 3)) & 3, a4 = (a1 + sft) >> 2;
        const LAS float* ct = CT + (hl * 4 + sft) * 384 + 128 + 4 * (4 * (2 * s_lo) + q - a4);
        float mx = sink;
#pragma unroll
        for (int r = 0; r < 10; ++r) { const f32x4 tb = *(const LAS f32x4*)(ct + 16 * r); const bool dead = (nb == 0) && (2 * s_lo + r < 8);
#pragma unroll
            for (int jj = 0; jj < 4; ++jj) { float sc = acc[r][jj] * 0.125f + tb[jj]; sc = dead ? NEG_INF : sc; acc[r][jj] = sc; mx = fmaxf(mx, sc); } }
        mx = fmaxf(mx, __shfl_xor(mx, 16)); mx = fmaxf(mx, __shfl_xor(mx, 32));
        float sum = 0.f;
#pragma unroll
        for (int r = 0; r < 10; ++r)
#pragma unroll
            for (int jj = 0; jj < 4; ++jj) { const float ev = __expf(acc[r][jj] - mx); acc[r][jj] = ev; sum += ev; }
        sum += __shfl_xor(sum, 16); sum += __shfl_xor(sum, 32);
        const float inv = 1.0f / (sum + __expf(sink - mx));
        f32x4 o[4];
#pragma unroll
        for (int df = 0; df < 4; ++df) o[df] = (f32x4){0.f, 0.f, 0.f, 0.f};
#pragma unroll
        for (int s = 0; s < 5; ++s) {
            u32x4v pw; pw.x = pk2(acc[2 * s][0], acc[2 * s][1]); pw.y = pk2(acc[2 * s][2], acc[2 * s][3]); pw.z = pk2(acc[2 * s + 1][0], acc[2 * s + 1][1]); pw.w = pk2(acc[2 * s + 1][2], acc[2 * s + 1][3]);
            const bf16x8 P = __builtin_bit_cast(bf16x8, pw);
#pragma unroll
            for (int df = 0; df < 4; ++df) { const LAS bf16_t* vp = VT + (16 * df + fr) * 272 + 32 * (s_lo + s) + 4 * q;
                const u32x2v lo = *(const LAS u32x2v*)vp, hi = *(const LAS u32x2v*)(vp + 16);
                u32x4v aw; aw.x = lo.x; aw.y = lo.y; aw.z = hi.x; aw.w = hi.y;
                o[df] = MFMA16(__builtin_bit_cast(bf16x8, aw), P, o[df]); }
        }
#pragma unroll
        for (int df = 0; df < 4; ++df) { u32x2v w; w.x = pk2(o[df][0] * inv, o[df][1] * inv); w.y = pk2(o[df][2] * inv, o[df][3] * inv);
            *(u32x2v*)(Y + gt * D + 256 + hq * 64 + 16 * df + 4 * q) = w; }
    }
}
__device__ __forceinline__ void attn_bias_table(const float* rel_bias, LAS unsigned char* lds, int tid) {
    LAS float* BT = (LAS float*)(lds + ATT_BT_OFF);
    for (int idx = tid; idx < 1024; idx += NTHR) { const int h = idx >> 7, dist = idx & 127;
        int bucket = dist;
        if (dist >= 16) bucket = 16 + (dist >= 19) + (dist >= 21) + (dist >= 24) + (dist >= 27) + (dist >= 31) + (dist >= 35) + (dist >= 40) + (dist >= 46) + (dist >= 52) + (dist >= 59) + (dist >= 67) + (dist >= 77) + (dist >= 87) + (dist >= 99) + (dist >= 113);
        BT[idx] = rel_bias[bucket * 8 + h]; }
}

constexpr int LDS_CTL_OFF = 147456 - 256;
#ifndef PROBE_PRE
#define PROBE_PRE 1
#endif
#ifndef PROBE_PREP
#define PROBE_PREP 1
#endif
#ifndef PROBE_P0
#define PROBE_P0 1
#endif
#ifndef PROBE_G1
#define PROBE_G1 1
#endif
#ifndef ATT_IN_PREP
#define ATT_IN_PREP 512
#endif
#ifndef GEMM_SP2
#define GEMM_SP2 true
#endif
#ifndef PROBE_G2
#define PROBE_G2 1
#endif
#ifndef REV_DOWN
#define REV_DOWN 0
#endif
#ifndef PROBE_G3
#define PROBE_G3 1
#endif
#ifndef CONV_LATE
#define CONV_LATE 0
#endif
#ifndef PROBE_LRUFIX
#define PROBE_LRUFIX 1
#endif
#ifndef PROBE_MAIN
#define PROBE_MAIN 1
#endif
#ifndef PROBE_SYNC
#define PROBE_SYNC 0
#endif
struct Args { const float* in[30]; float* out; unsigned char* ws; };
template <class Epi>
__device__ __forceinline__ void run_gemm(LAS unsigned char* lds, const bf16_t* A, const bf16_t* Bt, int N, int K, const Epi& E, int rev = 0, int gsz = 0, int grank = 0) {
    asm volatile("" : "+s"(K), "+s"(N));
    pg8::Gemm g{A, Bt, T, N, K}; pg8::StaticOrder S; S.init(T, N, gsz > 0 ? gsz : (int)gridDim.x, gsz > 0 ? grank : (int)blockIdx.x, rev);
    pg8::gemm_phase<Epi, pg8::StaticOrder, true, GEMM_SP2>(lds, g, S, E);
}
__global__ void __launch_bounds__(NTHR, 2) hymba_fwd(Args args) {
    extern __shared__ __attribute__((aligned(16))) unsigned char lds_raw[];
    LAS unsigned char* lds = (LAS unsigned char*)lds_raw;
    cg::grid_group grid = cg::this_grid();
    const int tid = threadIdx.x, lane = tid & 63, wave = __builtin_amdgcn_readfirstlane(tid >> 6);
    const int G = gridDim.x, bid = blockIdx.x;
    const int gw = bid * NWAVES + wave, ngw = G * NWAVES;
    const float* const* in = args.in;
    unsigned char* ws = args.ws;
    float* out = args.out;
    bf16_t* R1 = (bf16_t*)(ws + WS_R1);
    bf16_t* PBF = (bf16_t*)(ws + WS_R2 + R2_PBF);
    bf16_t* PBUF = (bf16_t*)(ws + WS_R2 + R2_PBUF);
    float* DNBA = (float*)(ws + WS_R2 + R2_DNBA);

    bf16_t* XA = (bf16_t*)(ws + WS_XN);
    bf16_t* YB = (bf16_t*)out;
    bf16_t* XB = (bf16_t*)(ws + WS_R2 + R2_XB);
    float* RSS = (float*)(ws + WS_RSS);
    if (bid == 0) for (int i = tid; i < XCD_BAR_WORDS; i += NTHR) ((unsigned*)ws)[i] = 0u;
    if (tid < 2) ((LAS unsigned*)(lds + LDS_CTL_OFF))[tid] = 0u;
    for (int rep = 0; rep < PROBE_P0; ++rep) {
    convert_weights(in, ws, (LAS float*)(lds + wave * 16384), gw, ngw, lane, 0, NL * CONV_PER_LAYER - CONV_LATE);
    rows_bf16_sumsq(in[0], XA, RSS, gw, ngw, lane);
    }
    grid.sync();
    const XcdBarrier xbar = xcd_barrier_post((unsigned*)ws, (volatile LAS unsigned*)(lds + LDS_CTL_OFF));
#define GSYNC() xcd_barrier(xbar)

    for (int l = 0; l < NL; ++l) {
        const unsigned char* wl = ws + WS_W + (size_t)l * W_LAYER;
        int tid = threadIdx.x; asm volatile("" : "+v"(tid)); int lane = tid & 63;
        const bf16_t* hin = (l == 0) ? XA : XB;
        float* rss0 = RSS, *rss1 = RSS + (size_t)4 * T, *rss2 = RSS, *rss3 = RSS + (size_t)4 * T, *rss4 = RSS;
        LAS float* part = (LAS float*)(lds + EPI_LDS_OFF);
        for (int rep = 0; rep < PROBE_G1; ++rep) {
        { EpiSwiglu E{R1, rss0}; run_gemm(lds, l == 0 ? XA : XB, (const bf16_t*)(wl + O_GU1), 2 * FF, D, E); }
        GSYNC();
        }
        for (int rep = 1; rep < (l == 0 ? PROBE_G2 : 1); ++rep) {
        { EpiResid E{hin, XB, 0.5f, rss1, part}; run_gemm(lds, R1, (const bf16_t*)(wl + O_D1), D, FF, E, REV_DOWN); }
        GSYNC();
        }
        { EpiResid E{hin, XA, 0.5f, rss1, part}; run_gemm(lds, R1, (const bf16_t*)(wl + O_D1), D, FF, E, REV_DOWN); }
        GSYNC();
        for (int rep = 0; rep < PROBE_G3; ++rep) {
        { EpiBf16<NIN, true> E{R1, DNBA, rss1}; run_gemm(lds, XA, (const bf16_t*)(wl + O_IN), NIN, D, E); }
        GSYNC();
        }
        for (int rep = 0; rep < PROBE_PRE; ++rep) {
        for (int it = bid; it < NBATCH * 64; it += G) mixer_pre_item(it, in, l, ws, lds, tid, lane, wave);
        { int t_ = threadIdx.x; asm volatile("" : "+v"(t_)); convert_p(in[1] + (size_t)l * T * PLE, PBF, (size_t)bid * NTHR + t_, (size_t)G * NTHR); }
        GSYNC();
        }
        for (int rep = 0; rep < PROBE_PREP; ++rep) {
            attn_bias_table(in[16], lds, tid);
            for (int b2 = G - 1 - bid; b2 < NBATCH; b2 += G) lru_carry_item(b2, ws, tid);
            for (int it = bid; it < NBATCH * 32; it += G) dn_prep_item(it, ws, lds, tid, lane, wave);
            for (int it = bid; it < ATT_IN_PREP; it += G) attn_item(511 - it, in, l, ws, YB, lds, tid, lane, wave);
            GSYNC();
        }
        for (int rep = 0; rep < PROBE_MAIN; ++rep) {
            if (ATT_IN_PREP < 512) { attn_bias_table(in[16], lds, tid); __syncthreads(); }
            if (G >= 128) {
                if (bid < 64) dn_chain_item(bid, in, l, ws, YB, lds, tid, lane, wave);
                else { const int r = bid - 64, R = G - 64;
                    for (int it = r; it < 512 - ATT_IN_PREP; it += R) attn_item(it, in, l, ws, YB, lds, tid, lane, wave);
                    for (int rep2 = 0; rep2 < PROBE_LRUFIX; ++rep2)
                    for (int it = r; it < NBATCH * 64; it += R) lru_fix_item(it, ws, YB, tid);
                    { __syncthreads(); EpiBf16<D, false> E{PBUF, nullptr, nullptr}; run_gemm(lds, PBF, (const bf16_t*)(wl + O_PP), D, PLE, E, 0, R, r); }
                    if (l == 0 && CONV_LATE > 0) { __syncthreads(); convert_weights(in, ws, (LAS float*)(lds + wave * 16384), r * NWAVES + wave, R * NWAVES, lane, NL * CONV_PER_LAYER - CONV_LATE, NL * CONV_PER_LAYER); }
                }
            } else {
                for (int it = bid; it < 64; it += G) dn_chain_item(it, in, l, ws, YB, lds, tid, lane, wave);
                attn_bias_table(in[16], lds, tid);
                for (int it = bid; it < 512 - ATT_IN_PREP; it += G) attn_item(it, in, l, ws, YB, lds, tid, lane, wave);
                for (int it = bid; it < NBATCH * 64; it += G) lru_fix_item(it, ws, YB, tid);
                { __syncthreads(); EpiBf16<D, false> E{PBUF, nullptr, nullptr}; run_gemm(lds, PBF, (const bf16_t*)(wl + O_PP), D, PLE, E); }
                if (l == 0 && CONV_LATE > 0) { __syncthreads(); convert_weights(in, ws, (LAS float*)(lds + wave * 16384), gw, ngw, lane, NL * CONV_PER_LAYER - CONV_LATE, NL * CONV_PER_LAYER); }
            }
            GSYNC();
        }
        { EpiResid E{XA, XA, 1.0f, rss2, part}; run_gemm(lds, YB, (const bf16_t*)(wl + O_OUT), D, D, E); }
        GSYNC();
        { EpiSwiglu E{R1, rss2}; run_gemm(lds, XA, (const bf16_t*)(wl + O_GU2), 2 * FF, D, E); }
        GSYNC();
        { EpiResid E{XA, XA, 0.5f, rss3, part}; run_gemm(lds, R1, (const bf16_t*)(wl + O_D2), D, FF, E, REV_DOWN); }
        GSYNC();
        { EpiPle E{XA, XB, PBUF, rss3, rss4, part}; run_gemm(lds, XA, (const bf16_t*)(wl + O_PG), D, D, E); }
        GSYNC();
    }
    final_norm_rows(XB, in[29], out, gw, ngw, lane);
}

extern "C" void kernel_launch(void* const* d_in, const int* in_sizes, int n_in, void* d_out, int out_size, void* d_ws, size_t ws_size, hipStream_t stream) {
    static int grid = 0;
    if (grid == 0) {
        if (n_in != 30 || out_size != T * D || ws_size < WS_END) { fprintf(stderr, "kernel_launch: unexpected shapes n_in %d out %d ws %zu (need %zu)\n", n_in, out_size, ws_size, (size_t)WS_END); grid = -1; return; }
        int dev = 0, cus = 0, per_cu = 0;
        (void)hipGetDevice(&dev);
        (void)hipDeviceGetAttribute(&cus, hipDeviceAttributeMultiprocessorCount, dev);
        (void)hipFuncSetAttribute((const void*)hymba_fwd, hipFuncAttributeMaxDynamicSharedMemorySize, LDS_BYTES);
        (void)hipOccupancyMaxActiveBlocksPerMultiprocessor(&per_cu, (const void*)hymba_fwd, NTHR, LDS_BYTES);
        if (per_cu < 1) per_cu = 1;
        (void)hipGetLastError();
        grid = cus * per_cu;
        fprintf(stderr, "kernel_launch: grid %d (cus %d x %d)\n", grid, cus, per_cu);
    }
    if (grid < 0) return;
    Args a{};
    for (int i = 0; i < 30; ++i) a.in[i] = (const float*)d_in[i];
    a.out = (float*)d_out; a.ws = (unsigned char*)d_ws;
    void* kargs[] = {&a};
    hipError_t e = hipLaunchCooperativeKernel((void*)hymba_fwd, dim3(grid), dim3(NTHR), kargs, LDS_BYTES, stream);
    if (e != hipSuccess) fprintf(stderr, "kernel_launch: cooperative launch failed: %s (grid %d)\n", hipGetErrorString(e), grid);
}
```

```cpp
#include <hip/hip_runtime.h>
#include <hip/hip_cooperative_groups.h>
#include <cstdio>
#include <cstdint>
namespace cg = cooperative_groups;
namespace pg8 {
#define PG8_LAS __attribute__((address_space(3)))
typedef unsigned short bf16_t;
typedef short bf16x8 __attribute__((ext_vector_type(8)));
typedef float f32x4 __attribute__((ext_vector_type(4)));
typedef unsigned u32x4 __attribute__((ext_vector_type(4)));
constexpr int BM = 256, BK = 64, HALF = 128, HTB = HALF * BK * 2  , STAGE_BYTES = 8 * HTB, NXCD = 8, WGM = 8;

__host__ __device__ __forceinline__ int lds_byte(int r, int c) { const int st = (r >> 4) * 2 + (c >> 5), rr = r & 15, cc = c & 31, ob = rr * 64 + cc * 2; return st * 1024 + (ob ^ (((ob >> 9) & 1) << 5)); }
__host__ __device__ __forceinline__ void stage_rc(int b, int& R, int& C) { const int st = b / 1024, sb = b % 1024, swz = sb ^ (((sb >> 9) & 1) << 5); R = (st >> 1) * 16 + swz / 64; C = (st & 1) * 32 + (swz % 64) / 2; }
__host__ __device__ __forceinline__ int perm32(int rho) { const int n = rho >> 4, i = rho & 15; return 8 * (i >> 2) + 4 * n + (i & 3); }

struct Unit { int pm, pn; };
struct Gemm { const bf16_t* A; const bf16_t* Bt; int M, N, K; };

struct StaticOrder {
    int nM, nN, nwg, G, c, rev;
    __host__ __device__ void init(int M, int N, int G_, int c_, int rev_ = 0) { nM = M / BM; nN = N / BM; nwg = nM * nN; G = G_; c = c_; rev = rev_; }
    __host__ __device__ bool next(int i, Unit& u) const {
        const long L = (long)i * G + c; if (L >= nwg) return false;
        int wgid = (int)L; { const int q = nwg / NXCD, r = nwg % NXCD, xcd = wgid % NXCD, off = wgid / NXCD; wgid = (xcd < r ? xcd * (q + 1) : r * (q + 1) + (xcd - r) * q) + off; }
        const int nig = WGM * nN, gid = wgid / nig, fm = gid * WGM, gsz = (nM - fm) < WGM ? (nM - fm) : WGM;
        u.pm = fm + ((wgid % nig) % gsz); u.pn = (wgid % nig) / gsz; if (rev) u.pm = nM - 1 - u.pm; return true;
    }
    __device__ __forceinline__ void a_ready(const Unit&) const {}
    __device__ __forceinline__ void done(const Unit&) const {}
};

__device__ __forceinline__ unsigned cvt_pk_bf16(float lo, float hi) { unsigned r; asm volatile("v_cvt_pk_bf16_f32 %0, %1, %2" : "=v"(r) : "v"(lo), "v"(hi)); return r; }
template <class Epi, class Sched, bool ALIGN_EPI = false, bool SP2 = false>
__device__ __forceinline__ void gemm_phase(PG8_LAS unsigned char* lds, const Gemm g, const Sched& S, const Epi& E) {
    int tid_ = threadIdx.x; asm volatile("" : "+v"(tid_));
    const int tid = tid_, wid = __builtin_amdgcn_readfirstlane(tid >> 6), lane = tid & 63, wr = wid >> 2, wc = wid & 3, fr = lane & 15, fq = lane >> 4;
    const int K = g.K, nt = K / BK;
    unsigned voffA[2], voffB[2];
#pragma unroll
    for (int i = 0; i < 2; ++i) { int R, C; stage_rc(tid * 16 + i * 8192, R, C); const int Rb = Epi::PERM ? ((R & ~31) + perm32(R & 31)) : R;
        voffA[i] = (unsigned)(R * K + C) * 2u; voffB[i] = (unsigned)(Rb * K + C) * 2u; }
    const size_t kstep = (size_t)(BK * 2);
    const size_t hstep = (size_t)HALF * K * 2;
    const size_t tstep = 2 * hstep;
    const unsigned ldsw = (unsigned)wid * 1024u;
    const int aoff = lds_byte(wr * 64 + fr, fq * 8), boff = lds_byte(wc * 32 + fr, fq * 8);
#define PG8_SA(b, h) (((b) * 2 + (h)) * HTB)
#define PG8_SB(b, h) ((4 + (b) * 2 + (h)) * HTB)
#define PG8_STAGE(bufoff, gbase, voff) do { _Pragma("unroll") for (int _i = 0; _i < 2; ++_i) \
        __builtin_amdgcn_global_load_lds((const unsigned*)((const char*)(gbase) + (voff)[_i]), (PG8_LAS unsigned*)(lds + (bufoff) + ldsw + _i * 8192), 16, 0, 0); } while (0)
#define PG8_LDA(dst, b, h) do { _Pragma("unroll") for (int m = 0; m < 4; ++m) _Pragma("unroll") for (int k = 0; k < 2; ++k) dst[m][k] = *(const PG8_LAS bf16x8*)(lds + PG8_SA(b, h) + aoff + m * 2048 + k * 1024); } while (0)
#define PG8_LDB(dst, b, h) do { _Pragma("unroll") for (int n = 0; n < 2; ++n) _Pragma("unroll") for (int k = 0; k < 2; ++k) dst[n][k] = *(const PG8_LAS bf16x8*)(lds + PG8_SB(b, h) + boff + n * 2048 + k * 1024); } while (0)
#define PG8_MMA(ai, bj, At, Bt) do { __builtin_amdgcn_s_setprio(1); _Pragma("unroll") for (int m = 0; m < 4; ++m) _Pragma("unroll") for (int n = 0; n < 2; ++n) _Pragma("unroll") for (int k = 0; k < 2; ++k) \
        acc[ai][bj][m][n] = __builtin_amdgcn_mfma_f32_16x16x32_bf16(Bt[n][k], At[m][k], acc[ai][bj][m][n], 0, 0, 0); __builtin_amdgcn_s_setprio(0); } while (0)
#define PG8_WAIT_V(n) asm volatile("s_waitcnt vmcnt(" #n ")" ::: "memory")
#define PG8_WAIT_L(n) asm volatile("s_waitcnt lgkmcnt(" #n ")" ::: "memory")
#define PG8_BAR __builtin_amdgcn_s_barrier()
#define PG8_SCHED __builtin_amdgcn_sched_barrier(0)
    Unit cur, nxt; int ui = 0;
    if (!S.next(0, cur)) return;
    f32x4 acc[2][2][4][2];
#pragma unroll
    for (int a = 0; a < 2; ++a)
#pragma unroll
        for (int b = 0; b < 2; ++b)
#pragma unroll
            for (int m = 0; m < 4; ++m)
#pragma unroll
                for (int n = 0; n < 2; ++n) acc[a][b][m][n] = (f32x4){0.f, 0.f, 0.f, 0.f};
    bf16x8 At[4][2], B0[2][2], B1[2][2];
    const char* cA = (const char*)g.A + (size_t)cur.pm * tstep; const char* cB = (const char*)g.Bt + (size_t)cur.pn * tstep;
    S.a_ready(cur);
    if constexpr (SP2) {
        PG8_STAGE(PG8_SB(0, 0), cB, voffB); PG8_STAGE(PG8_SB(0, 1), cB + hstep, voffB); PG8_STAGE(PG8_SA(0, 0), cA, voffA); PG8_STAGE(PG8_SA(0, 1), cA + hstep, voffA);
        if (wr == 1) PG8_BAR;
        PG8_WAIT_V(2); PG8_BAR;
        PG8_STAGE(PG8_SB(1, 0), cB + kstep, voffB); PG8_STAGE(PG8_SA(1, 0), cA + kstep, voffA); PG8_STAGE(PG8_SB(1, 1), cB + hstep + kstep, voffB);
        PG8_WAIT_V(6); PG8_BAR;
    } else {
        PG8_STAGE(PG8_SB(0, 0), cB, voffB); PG8_STAGE(PG8_SA(0, 0), cA, voffA); PG8_STAGE(PG8_SB(0, 1), cB + hstep, voffB); PG8_STAGE(PG8_SA(0, 1), cA + hstep, voffA);
        if (wr == 1) PG8_BAR;
        PG8_WAIT_V(4); PG8_BAR;
        PG8_STAGE(PG8_SB(1, 0), cB + kstep, voffB); PG8_STAGE(PG8_SA(1, 0), cA + kstep, voffA); PG8_STAGE(PG8_SB(1, 1), cB + hstep + kstep, voffB);
        PG8_WAIT_V(6); PG8_BAR;
    }
    for (;;) {
        const bool has_next = S.next(ui + 1, nxt);
        const char* nA = has_next ? (const char*)g.A + (size_t)nxt.pm * tstep : cA; const char* nB = has_next ? (const char*)g.Bt + (size_t)nxt.pn * tstep : cB;
        for (int t = 0; t < nt; t += 2) {
            const bool last = (t == nt - 2);
            const char* a1 = cA + (size_t)(t + 1) * kstep;
            const char* a2 = last ? nA : cA + (size_t)(t + 2) * kstep; const char* b2 = last ? nB : cB + (size_t)(t + 2) * kstep;
            const char* a3 = a2 + kstep; const char* b3 = b2 + kstep;
            if (last && has_next) S.a_ready(nxt);
            if constexpr (SP2) {
            PG8_LDB(B0, 0, 0); PG8_LDB(B1, 0, 1); PG8_SCHED; PG8_LDA(At, 0, 0); PG8_STAGE(PG8_SA(1, 1), a1 + hstep, voffA);
            PG8_WAIT_V(8); PG8_WAIT_L(0); PG8_BAR; PG8_MMA(0, 0, At, B0); PG8_MMA(0, 1, At, B1); PG8_BAR; PG8_SCHED;
            PG8_LDA(At, 0, 1); PG8_STAGE(PG8_SB(0, 0), b2, voffB); PG8_STAGE(PG8_SB(0, 1), b2 + hstep, voffB); PG8_STAGE(PG8_SA(0, 0), a2, voffA);
            PG8_WAIT_V(8); PG8_WAIT_L(0); PG8_BAR; PG8_MMA(1, 0, At, B0); PG8_MMA(1, 1, At, B1); PG8_BAR; PG8_SCHED;
            PG8_LDB(B0, 1, 0); PG8_LDB(B1, 1, 1); PG8_SCHED; PG8_LDA(At, 1, 0); PG8_STAGE(PG8_SA(0, 1), a2 + hstep, voffA);
            PG8_WAIT_V(8); PG8_WAIT_L(0); PG8_BAR; PG8_MMA(0, 0, At, B0); PG8_MMA(0, 1, At, B1); PG8_BAR; PG8_SCHED;
            PG8_LDA(At, 1, 1); PG8_STAGE(PG8_SB(1, 0), b3, voffB); PG8_STAGE(PG8_SB(1, 1), b3 + hstep, voffB); PG8_STAGE(PG8_SA(1, 0), a3, voffA);
            PG8_WAIT_V(8); PG8_WAIT_L(0); PG8_BAR; PG8_MMA(1, 0, At, B0); PG8_MMA(1, 1, At, B1); PG8_BAR; PG8_SCHED;
            } else {
            PG8_LDB(B0, 0, 0); PG8_SCHED; PG8_LDA(At, 0, 0); PG8_STAGE(PG8_SA(1, 1), a1 + hstep, voffA);
            PG8_WAIT_L(8); PG8_BAR; PG8_WAIT_L(0); PG8_MMA(0, 0, At, B0); PG8_BAR; PG8_SCHED;
            PG8_LDB(B1, 0, 1); PG8_STAGE(PG8_SB(0, 0), b2, voffB);
            PG8_BAR; PG8_WAIT_L(0); PG8_MMA(0, 1, At, B1); PG8_BAR;
            PG8_LDA(At, 0, 1); PG8_STAGE(PG8_SA(0, 0), a2, voffA);
            PG8_BAR; PG8_WAIT_L(0); PG8_MMA(1, 0, At, B0); PG8_BAR; PG8_SCHED;
            PG8_STAGE(PG8_SB(0, 1), b2 + hstep, voffB);
            PG8_WAIT_V(6); PG8_BAR; PG8_MMA(1, 1, At, B1); PG8_BAR;
            PG8_LDB(B0, 1, 0); PG8_SCHED; PG8_LDA(At, 1, 0); PG8_STAGE(PG8_SA(0, 1), a2 + hstep, voffA);
            PG8_WAIT_L(8); PG8_BAR; PG8_WAIT_L(0); PG8_MMA(0, 0, At, B0); PG8_BAR; PG8_SCHED;
            PG8_LDB(B1, 1, 1); PG8_STAGE(PG8_SB(1, 0), b3, voffB);
            PG8_BAR; PG8_WAIT_L(0); PG8_MMA(0, 1, At, B1); PG8_BAR;
            PG8_LDA(At, 1, 1); PG8_STAGE(PG8_SA(1, 0), a3, voffA);
            PG8_BAR; PG8_WAIT_L(0); PG8_MMA(1, 0, At, B0); PG8_BAR; PG8_SCHED;
            PG8_STAGE(PG8_SB(1, 1), b3 + hstep, voffB);
            PG8_WAIT_V(6); PG8_BAR; PG8_MMA(1, 1, At, B1); PG8_BAR;
            }
        }
        if constexpr (ALIGN_EPI) { if (wr == 0) PG8_BAR; }
        if constexpr (!Epi::AFTER_DRAIN) { E(acc, cur, wr, wc, fr, fq); S.done(cur); }
        if (!has_next) break;
#pragma unroll
        for (int a = 0; a < 2; ++a)
#pragma unroll
            for (int b = 0; b < 2; ++b)
#pragma unroll
                for (int m = 0; m < 4; ++m)
#pragma unroll
                    for (int n = 0; n < 2; ++n) acc[a][b][m][n] = (f32x4){0.f, 0.f, 0.f, 0.f};
        cur = nxt; cA = nA; cB = nB; ++ui;
        if constexpr (ALIGN_EPI) { if (wr == 1) PG8_BAR; }
    }
    PG8_WAIT_V(0);
    if constexpr (!ALIGN_EPI) { if (wr == 0) PG8_BAR; }
    PG8_BAR;
    if constexpr (Epi::AFTER_DRAIN) { E.fused(acc, cur, wr, wc, fr, fq, lds, wid, lane); S.done(cur); }
#undef PG8_SA
#undef PG8_SB
#undef PG8_STAGE
#undef PG8_LDA
#undef PG8_LDB
#undef PG8_MMA
#undef PG8_WAIT_V
#undef PG8_WAIT_L
#undef PG8_BAR
#undef PG8_SCHED
}
}

#define LAS __attribute__((address_space(3)))
typedef pg8::bf16_t bf16_t;
typedef pg8::f32x4 f32x4;
typedef pg8::bf16x8 bf16x8;
typedef unsigned u32x4v __attribute__((ext_vector_type(4)));
typedef unsigned u32x2v __attribute__((ext_vector_type(2)));
typedef short s16x4 __attribute__((ext_vector_type(4)));
constexpr int NBATCH = 16, SEQ = 2048, T = NBATCH * SEQ, D = 1024, FF = 2816, DIN = 2312, NIN = 2560, PLE = 256, NL = 2;
constexpr int U_LRUX = 0, U_LRUG = 256, U_AQ = 512, U_AK = 1024, U_AV = 1152, U_DQ = 1280, U_DZ = 2048;
constexpr float EPS = 1e-6f;
constexpr int NTHR = 512, NWAVES = 8;
constexpr int LDS_BYTES = 147456;
constexpr size_t MiB = 1u << 20;
constexpr size_t SZ_GU = 5632ull * 1024 * 2, SZ_DN = 1024ull * 2816 * 2, SZ_IN = 2560ull * 1024 * 2, SZ_SQ = 1024ull * 1024 * 2, SZ_PP = 1024ull * 256 * 2, SZ_LRU = 2ull * 4 * 64 * 64 * 2;
constexpr size_t O_GU1 = 0, O_D1 = O_GU1 + SZ_GU, O_GU2 = O_D1 + SZ_DN, O_D2 = O_GU2 + SZ_GU, O_IN = O_D2 + SZ_DN, O_OUT = O_IN + SZ_IN, O_PG = O_OUT + SZ_SQ, O_PP = O_PG + SZ_SQ, O_LRU = O_PP + SZ_PP, W_LAYER = O_LRU + SZ_LRU;
constexpr size_t WS_W = 1 * MiB, WS_XN = 89 * MiB, WS_R1 = 153 * MiB, WS_R2 = 329 * MiB, WS_END = 512 * MiB;
static_assert(WS_W + NL * W_LAYER <= WS_XN, "weights fit");
static_assert((size_t)T * FF * 2 <= WS_R2 - WS_R1, "act fits R1");
constexpr size_t R2_LH = 0, R2_PC = 16 * MiB, R2_AGG = 32 * MiB, R2_DQ = 34 * MiB, R2_DK = 50 * MiB, R2_DV = 66 * MiB, R2_UU = 82 * MiB, R2_GG = 98 * MiB, R2_BE = 98 * MiB + 512 * 1024, R2_DNBA = 99 * MiB,
                 R2_WW = 100 * MiB, R2_QG = 116 * MiB, R2_ATT = 132 * MiB, R2_KDT = 148 * MiB, R2_EGL = 164 * MiB, R2_USED = 165 * MiB;
constexpr size_t R2_CARRY = 181 * MiB;
static_assert(WS_R2 + R2_CARRY + (size_t)NBATCH * 64 * 256 * 4 <= WS_END, "carry fits");
constexpr size_t WS_UU = WS_R1 + 160 * MiB;
constexpr size_t R2_PBF = 165 * MiB, R2_PBUF = 34 * MiB, R2_XB = 100 * MiB;
static_assert(WS_UU + (size_t)T * 256 * 2 <= WS_R2 && R2_PBUF + (size_t)T * D * 2 <= 98 * MiB && R2_XB + (size_t)T * D * 2 <= 164 * MiB, "map");
constexpr size_t WS_RSS = 87 * MiB;
static_assert(WS_W + NL * W_LAYER <= WS_RSS && WS_RSS + 2 * 4 * (size_t)T * 4 <= WS_XN && R2_PBF + (size_t)T * PLE * 2 <= WS_END - WS_R2, "map");
static_assert(WS_R2 + R2_USED <= WS_END, "R2 fits");

__device__ __forceinline__ float bf2f(unsigned short b) { return __uint_as_float(((unsigned)b) << 16); }
__device__ __forceinline__ float bflo(unsigned w) { return __uint_as_float(w << 16); }
__device__ __forceinline__ float bfhi(unsigned w) { return __uint_as_float(w & 0xffff0000u); }
__device__ __forceinline__ unsigned pk2(float lo, float hi) { return pg8::cvt_pk_bf16(lo, hi); }
__device__ __forceinline__ unsigned short f2bf(float f) { return (unsigned short)(pg8::cvt_pk_bf16(f, 0.f) & 0xffffu); }
__device__ __forceinline__ float sigmoidf_(float x) { return __builtin_amdgcn_rcpf(1.0f + __expf(-x)); }
__device__ __forceinline__ float siluf_(float x) { return x * __builtin_amdgcn_rcpf(1.0f + __expf(-x)); }
__device__ __forceinline__ float softplusf_(float x) { const float e = __expf(-fabsf(x)); const float lg = (e < 0.03f) ? e * (1.0f - e * (0.5f - e * (0.33333334f - 0.25f * e))) : __logf(1.0f + e); return fmaxf(x, 0.f) + lg; }
__device__ __forceinline__ float gelu_tanh(float x) { const float u2 = 1.5957691216057308f * (x + 0.044715f * x * x * x); return x * __builtin_amdgcn_rcpf(1.0f + __expf(-u2)); }
#define DPP_ADD(v, ctrl) do { const int _t = __builtin_amdgcn_update_dpp(0, __builtin_bit_cast(int, (v)), (ctrl), 0xf, 0xf, true); (v) += __builtin_bit_cast(float, _t); } while (0)
__device__ __forceinline__ float wave_sum(float v) {
    DPP_ADD(v, 0xB1); DPP_ADD(v, 0x4E); DPP_ADD(v, 0x141); DPP_ADD(v, 0x140);
    const int vi = __builtin_bit_cast(int, v);
    const float r0 = __builtin_bit_cast(float, __builtin_amdgcn_readlane(vi, 0)), r1 = __builtin_bit_cast(float, __builtin_amdgcn_readlane(vi, 16)), r2 = __builtin_bit_cast(float, __builtin_amdgcn_readlane(vi, 32)), r3 = __builtin_bit_cast(float, __builtin_amdgcn_readlane(vi, 48));
    return (r0 + r1) + (r2 + r3);
}

__device__ __forceinline__ float rstd_of(const float* rss, int row) { const f32x4 p = *(const f32x4*)(rss + (size_t)row * 4); return 1.0f / sqrtf(((p[0] + p[1]) + (p[2] + p[3])) * (1.0f / D) + EPS); }
constexpr int EPI_LDS_OFF = 131072;
using pg8::Unit;
struct EpiSwiglu {
    static constexpr bool PERM = true, AFTER_DRAIN = false;
    bf16_t* O_; const float* rss_;
    __device__ __forceinline__ void operator()(const f32x4 (&acc)[2][2][4][2], const Unit& u, int wr, int wc, int fr, int fq) const {
        bf16_t* O = O_; const float* rss = rss_; asm volatile("" : "+s"(O), "+s"(rss));
        const int row0 = u.pm * 256 + wr * 64 + fr, col0 = u.pn * 128 + wc * 32 + 8 * fq;
        float rsv[2][4];
        { f32x4 pp[2][4];
#pragma unroll
          for (int ai = 0; ai < 2; ++ai)
#pragma unroll
            for (int m = 0; m < 4; ++m) pp[ai][m] = *(const f32x4*)(rss + (size_t)(row0 + ai * 128 + m * 16) * 4);
#pragma unroll
          for (int ai = 0; ai < 2; ++ai)
#pragma unroll
            for (int m = 0; m < 4; ++m) rsv[ai][m] = __builtin_amdgcn_rsqf(((pp[ai][m][0] + pp[ai][m][1]) + (pp[ai][m][2] + pp[ai][m][3])) * (1.0f / D) + EPS); }
#pragma unroll
        for (int ai = 0; ai < 2; ++ai)
#pragma unroll
            for (int m = 0; m < 4; ++m) {
                bf16_t* rowp = O + (size_t)(row0 + ai * 128 + m * 16) * FF + col0;
                const float rs = rsv[ai][m];
                float v[8];
#pragma unroll
                for (int n = 0; n < 2; ++n)
#pragma unroll
                    for (int j = 0; j < 4; ++j) { const float g = acc[ai][0][m][n][j] * rs, up = acc[ai][1][m][n][j] * rs; v[n * 4 + j] = g * __builtin_amdgcn_rcpf(1.0f + __expf(-g)) * up; }
                u32x4v w; w.x = pk2(v[0], v[1]); w.y = pk2(v[2], v[3]); w.z = pk2(v[4], v[5]); w.w = pk2(v[6], v[7]);
                *(u32x4v*)rowp = w;
            }
    }
};
struct EpiResid {
    static constexpr bool PERM = false, AFTER_DRAIN = false;
    const bf16_t* in_; bf16_t* out_; float scale_; float* rss_; LAS float* part;
    __device__ __forceinline__ void operator()(const f32x4 (&acc)[2][2][4][2], const Unit& u, int wr, int wc, int fr, int fq) const {
        const bf16_t* in = in_; bf16_t* out = out_; float scale = scale_; float* rss = rss_;
        asm volatile("" : "+s"(in), "+s"(out), "+s"(scale), "+s"(rss));
        const int row0 = u.pm * 256 + wr * 64 + fr, col0 = u.pn * 256 + wc * 32 + 4 * fq;
#pragma unroll
        for (int hb = 0; hb < 2; ++hb) {
            u32x2v rin[4][4];
#pragma unroll
            for (int gg = 0; gg < 4; ++gg) { const int g = hb * 4 + gg; const size_t offn = (size_t)(row0 + (g >> 2) * 128 + (g & 3) * 16) * D + col0;
#pragma unroll
                for (int k = 0; k < 4; ++k) rin[gg][k] = *(const u32x2v*)(in + offn + (k >> 1) * 128 + (k & 1) * 16); }
#pragma unroll
            for (int gg = 0; gg < 4; ++gg) {
                const int g = hb * 4 + gg, ai = g >> 2, m = g & 3, row = row0 + ai * 128 + m * 16;
                const size_t off = (size_t)row * D + col0;
                float ss = 0.f;
#pragma unroll
                for (int k = 0; k < 4; ++k) { const int bj = k >> 1, n = k & 1; const size_t o = off + bj * 128 + n * 16; const f32x4 a = acc[ai][bj][m][n] * scale; const u32x2v w0 = rin[gg][k];
                    f32x4 r; r[0] = bflo(w0.x) + a[0]; r[1] = bfhi(w0.x) + a[1]; r[2] = bflo(w0.y) + a[2]; r[3] = bfhi(w0.y) + a[3];
                    u32x2v w; w.x = pk2(r[0], r[1]); w.y = pk2(r[2], r[3]); *(u32x2v*)(out + o) = w; ss += (r[0] * r[0] + r[1] * r[1]) + (r[2] * r[2] + r[3] * r[3]); }
                ss += __shfl_xor(ss, 16); ss += __shfl_xor(ss, 32);
                if (fq == 0) part[(ai * 128 + wr * 64 + m * 16 + fr) * 4 + wc] = ss;
            }
        }
        asm volatile("s_waitcnt lgkmcnt(0)" ::: "memory"); __builtin_amdgcn_s_barrier(); asm volatile("" ::: "memory");
        { int t = threadIdx.x; asm volatile("" : "+v"(t)); if (t < 256) { const f32x4 p = *(const LAS f32x4*)(part + t * 4); rss[(size_t)(u.pm * 256 + t) * 4 + u.pn] = (p[0] + p[1]) + (p[2] + p[3]); } }
    }
};
template <int LD, bool SIDE> struct EpiBf16 {
    static constexpr bool PERM = true, AFTER_DRAIN = false;
    bf16_t* O_; float* side_; const float* rss_;
    __device__ __forceinline__ void operator()(const f32x4 (&acc)[2][2][4][2], const Unit& u, int wr, int wc, int fr, int fq) const {
        bf16_t* O = O_; float* side = side_; const float* rss = rss_; asm volatile("" : "+s"(O), "+s"(side), "+s"(rss));
        const int row0 = u.pm * 256 + wr * 64 + fr, col0 = u.pn * 256 + wc * 32 + 8 * fq;
        float rsv[2][4];
        if (SIDE) { f32x4 pp[2][4];
#pragma unroll
          for (int ai = 0; ai < 2; ++ai)
#pragma unroll
            for (int m = 0; m < 4; ++m) pp[ai][m] = *(const f32x4*)(rss + (size_t)(row0 + ai * 128 + m * 16) * 4);
#pragma unroll
          for (int ai = 0; ai < 2; ++ai)
#pragma unroll
            for (int m = 0; m < 4; ++m) rsv[ai][m] = __builtin_amdgcn_rsqf(((pp[ai][m][0] + pp[ai][m][1]) + (pp[ai][m][2] + pp[ai][m][3])) * (1.0f / D) + EPS); }
#pragma unroll
        for (int ai = 0; ai < 2; ++ai)
#pragma unroll
            for (int m = 0; m < 4; ++m) {
                const int row = row0 + ai * 128 + m * 16;
                bf16_t* rowp = O + (size_t)row * LD + col0;
                const float rs = SIDE ? rsv[ai][m] : 1.0f;
#pragma unroll
                for (int bj = 0; bj < 2; ++bj) {
                    const f32x4 v0 = acc[ai][bj][m][0] * rs, v1 = acc[ai][bj][m][1] * rs;
                    u32x4v w; w.x = pk2(v0[0], v0[1]); w.y = pk2(v0[2], v0[3]); w.z = pk2(v1[0], v1[1]); w.w = pk2(v1[2], v1[3]);
                    *(u32x4v*)(rowp + bj * 128) = w;
                    if (SIDE) { if (bj == 0 && u.pn == 9 && wc == 0 && fq == 0) { *(f32x4*)(side + (size_t)row * 8) = v0; *(f32x4*)(side + (size_t)row * 8 + 4) = v1; } }
                }
            }
    }
};
struct EpiPle {
    static constexpr bool PERM = false, AFTER_DRAIN = false;
    const bf16_t* in_; bf16_t* out_; const bf16_t* P_; const float* rss_; float* rss_out_; LAS float* part;
    __device__ __forceinline__ void operator()(const f32x4 (&acc)[2][2][4][2], const Unit& u, int wr, int wc, int fr, int fq) const {
        const bf16_t* in = in_; bf16_t* out = out_; const bf16_t* P = P_; const float* rss = rss_; float* rss_out = rss_out_;
        asm volatile("" : "+s"(in), "+s"(out), "+s"(P), "+s"(rss), "+s"(rss_out));
        const int row0 = u.pm * 256 + wr * 64 + fr, col0 = u.pn * 256 + wc * 32 + 4 * fq;
        float rsv[8];
        { f32x4 pp[8];
#pragma unroll
          for (int g = 0; g < 8; ++g) pp[g] = *(const f32x4*)(rss + (size_t)(row0 + (g >> 2) * 128 + (g & 3) * 16) * 4);
#pragma unroll
          for (int g = 0; g < 8; ++g) rsv[g] = __builtin_amdgcn_rsqf(((pp[g][0] + pp[g][1]) + (pp[g][2] + pp[g][3])) * (1.0f / D) + EPS); }
#pragma unroll
        for (int hb = 0; hb < 4; ++hb) {
            u32x2v rin[2][4], pin[2][4];
#pragma unroll
            for (int gg = 0; gg < 2; ++gg) { const int g = hb * 2 + gg; const size_t offn = (size_t)(row0 + (g >> 2) * 128 + (g & 3) * 16) * D + col0;
#pragma unroll
                for (int k = 0; k < 4; ++k) { const size_t o = offn + (k >> 1) * 128 + (k & 1) * 16; rin[gg][k] = *(const u32x2v*)(in + o); pin[gg][k] = *(const u32x2v*)(P + o); } }
#pragma unroll
            for (int gg = 0; gg < 2; ++gg) {
                const int g = hb * 2 + gg, ai = g >> 2, m = g & 3, row = row0 + ai * 128 + m * 16;
                const size_t off = (size_t)row * D + col0;
                const float rs = rsv[g];
                float ss = 0.f;
#pragma unroll
                for (int k = 0; k < 4; ++k) { const int bj = k >> 1, n = k & 1; const size_t o = off + bj * 128 + n * 16;
                    const u32x2v rw = rin[gg][k], pw = pin[gg][k]; const f32x4 a = acc[ai][bj][m][n] * rs;
                    f32x4 res; res[0] = bflo(rw.x) + sigmoidf_(a[0]) * bflo(pw.x); res[1] = bfhi(rw.x) + sigmoidf_(a[1]) * bfhi(pw.x); res[2] = bflo(rw.y) + sigmoidf_(a[2]) * bflo(pw.y); res[3] = bfhi(rw.y) + sigmoidf_(a[3]) * bfhi(pw.y);
                    u32x2v w; w.x = pk2(res[0], res[1]); w.y = pk2(res[2], res[3]); *(u32x2v*)(out + o) = w; ss += (res[0] * res[0] + res[1] * res[1]) + (res[2] * res[2] + res[3] * res[3]); }
                ss += __shfl_xor(ss, 16); ss += __shfl_xor(ss, 32); if (fq == 0) part[(ai * 128 + wr * 64 + m * 16 + fr) * 4 + wc] = ss;
            }
        }
        asm volatile("s_waitcnt lgkmcnt(0)" ::: "memory"); __builtin_amdgcn_s_barrier(); asm volatile("" ::: "memory");
        { int t = threadIdx.x; asm volatile("" : "+v"(t)); if (t < 256) { const f32x4 p = *(const LAS f32x4*)(part + t * 4); rss_out[(size_t)(u.pm * 256 + t) * 4 + u.pn] = (p[0] + p[1]) + (p[2] + p[3]); } }
    }
};

struct ConvItem { const float* W; const float* gain; bf16_t* WT; int N, ldk, drow0, k0, n0; };
constexpr int CONV_PER_LAYER = 4 * 16 * 88 + 2 * 44 * 32 + 16 * 80 + 2 * 16 * 32 + 4 * 32 + 2 * 8;
__device__ __forceinline__ ConvItem conv_decode(const float* const* in, unsigned char* ws, int it) {
    constexpr int I_GU = 16 * 88, I_DN = 44 * 32, I_IN = 16 * 80, I_SQ = 16 * 32, I_PP = 4 * 32, I_LR = 8;
    static_assert(4 * I_GU + 2 * I_DN + I_IN + 2 * I_SQ + I_PP + 2 * I_LR == CONV_PER_LAYER, "items");
    const int l = it / CONV_PER_LAYER; int r = it % CONV_PER_LAYER;
    unsigned char* wl = ws + WS_W + (size_t)l * W_LAYER;
    ConvItem c;
    if (r < 4 * I_GU) {
        const int which = r / I_GU; r %= I_GU;
        const int kb = r / 88, nb = r % 88, n0 = nb * 32;
        c.W = in[which == 0 ? 3 : which == 1 ? 4 : which == 2 ? 23 : 24] + (size_t)l * D * FF; c.gain = in[which < 2 ? 2 : 22] + l * D; c.WT = (bf16_t*)(wl + (which < 2 ? O_GU1 : O_GU2));
        c.N = FF; c.ldk = D; c.drow0 = (n0 / 128) * 256 + (n0 % 128) + (which & 1) * 128; c.k0 = kb * 64; c.n0 = n0; return c; }
    r -= 4 * I_GU;
    if (r < 2 * I_DN) { const int which = r / I_DN; r %= I_DN; const int kb = r / 32, nb = r % 32;
        c.W = in[which == 0 ? 5 : 25] + (size_t)l * FF * D; c.gain = nullptr; c.WT = (bf16_t*)(wl + (which == 0 ? O_D1 : O_D2)); c.N = D; c.ldk = FF; c.drow0 = nb * 32; c.k0 = kb * 64; c.n0 = nb * 32; return c; }
    r -= 2 * I_DN;
    if (r < I_IN) { const int kb = r / 80, nb = r % 80;
        c.W = in[7] + (size_t)l * D * DIN; c.gain = in[6] + l * D; c.WT = (bf16_t*)(wl + O_IN); c.N = DIN; c.ldk = D; c.drow0 = nb * 32; c.k0 = kb * 64; c.n0 = nb * 32; return c; }
    r -= I_IN;
    if (r < 2 * I_SQ) { const int which = r / I_SQ; r %= I_SQ; const int kb = r / 32, nb = r % 32;
        c.W = in[which == 0 ? 21 : 27] + (size_t)l * D * D; c.gain = which == 0 ? nullptr : in[26] + l * D; c.WT = (bf16_t*)(wl + (which == 0 ? O_OUT : O_PG)); c.N = D; c.ldk = D; c.drow0 = nb * 32; c.k0 = kb * 64; c.n0 = nb * 32; return c; }
    r -= 2 * I_SQ;
    if (r < I_PP) { const int kb = r / 32, nb = r % 32;
        c.W = in[28] + (size_t)l * PLE * D; c.gain = nullptr; c.WT = (bf16_t*)(wl + O_PP); c.N = D; c.ldk = PLE; c.drow0 = nb * 32; c.k0 = kb * 64; c.n0 = nb * 32; return c; }
    r -= I_PP;
    {
        const int which = r / I_LR; r %= I_LR; const int hb = r / 2, nb = r % 2;
        c.W = in[which == 0 ? 10 : 12] + (size_t)l * 4 * 4096 + hb * 4096; c.gain = nullptr; c.WT = (bf16_t*)(wl + O_LRU) + which * 16384 + hb * 4096; c.N = 64; c.ldk = 64; c.drow0 = nb * 32; c.k0 = 0; c.n0 = nb * 32; return c; }
}
__device__ __forceinline__ void conv_load(const ConvItem& c, int lane, float (&v)[32], float (&g)[32]) {
    const int n = c.n0 + (lane & 31); const bool ok = n < c.N;
#pragma unroll
    for (int i = 0; i < 32; ++i) { const int kk = 2 * i + (lane >> 5); v[i] = ok ? c.W[(size_t)(c.k0 + kk) * c.N + n] : 0.f; g[i] = c.gain ? c.gain[c.k0 + kk] : 1.0f; }
}
__device__ __forceinline__ void conv_finish(const ConvItem& c, int lane, const float (&v)[32], const float (&g)[32], LAS float* scr) {
#pragma unroll
    for (int i = 0; i < 32; ++i) { const int kk = 2 * i + (lane >> 5); scr[kk * 33 + (lane & 31)] = v[i] * g[i]; }
    asm volatile("s_waitcnt lgkmcnt(0)" ::: "memory");
    const int cc = lane & 7;
#pragma unroll
    for (int j = 0; j < 4; ++j) { const int n = (lane >> 3) + 8 * j; const LAS float* s = scr + (8 * cc) * 33 + n;
        u32x4v o; o.x = pk2(s[0 * 33], s[1 * 33]); o.y = pk2(s[2 * 33], s[3 * 33]); o.z = pk2(s[4 * 33], s[5 * 33]); o.w = pk2(s[6 * 33], s[7 * 33]);
        *(u32x4v*)(c.WT + (size_t)(c.drow0 + n) * c.ldk + c.k0 + 8 * cc) = o; }
    asm volatile("s_waitcnt lgkmcnt(0)" ::: "memory");
}
__device__ __forceinline__ void convert_weights(const float* const* in, unsigned char* ws, LAS float* scr, int gw, int ngw, int lane, int it_lo, int it_hi) {
    asm volatile("" : "+v"(lane));
    int it = it_lo + gw;
    if (it >= it_hi) return;
    ConvItem cur = conv_decode(in, ws, it);
    float va[32], ga[32], vb[32], gb[32];
    conv_load(cur, lane, va, ga);
    for (;;) {
        const int nx = it + ngw; const bool more = nx < it_hi;
        ConvItem nxt = cur;
        if (more) { nxt = conv_decode(in, ws, nx); conv_load(nxt, lane, vb, gb); }
        conv_finish(cur, lane, va, ga, scr);
        if (!more) break;
#pragma unroll
        for (int i = 0; i < 32; ++i) { va[i] = vb[i]; ga[i] = gb[i]; }
        cur = nxt; it = nx;
    }
}

__device__ __forceinline__ void rows_bf16_sumsq(const float* h, bf16_t* xn, float* rss, int gw, int ngw, int lane) {
    asm volatile("" : "+v"(lane));
    for (int m0 = gw; m0 < T; m0 += 2 * ngw) {
        const int m1 = (m0 + ngw < T) ? m0 + ngw : m0;
        f32x4 va[4], vb[4];
#pragma unroll
        for (int j = 0; j < 4; ++j) { va[j] = ((const f32x4*)(h + (size_t)m0 * D) + lane)[64 * j]; vb[j] = ((const f32x4*)(h + (size_t)m1 * D) + lane)[64 * j]; }
#pragma unroll
        for (int rr = 0; rr < 2; ++rr) {
            const int m = rr == 0 ? m0 : m1;
            float s = 0.f;
#pragma unroll
            for (int j = 0; j < 4; ++j) { const f32x4 v = rr == 0 ? va[j] : vb[j]; s += (v[0] * v[0] + v[1] * v[1]) + (v[2] * v[2] + v[3] * v[3]); }
            s = wave_sum(s);
            if (rr == 0 || m1 != m0) {
                u32x2v* o8 = (u32x2v*)(xn + (size_t)m * D) + lane;
#pragma unroll
                for (int j = 0; j < 4; ++j) { const f32x4 v = rr == 0 ? va[j] : vb[j]; u32x2v w; w.x = pk2(v[0], v[1]); w.y = pk2(v[2], v[3]); o8[64 * j] = w; }
                if (lane == 0) *(f32x4*)(rss + (size_t)m * 4) = (f32x4){s, 0.f, 0.f, 0.f};
            }
        }
    }
}
__device__ __forceinline__ void norm_rows_bf16(const float* h, const float* g, bf16_t* xn, int gw, int ngw, int lane) {
    asm volatile("" : "+v"(lane));
    f32x4 gv[4];
#pragma unroll
    for (int j = 0; j < 4; ++j) gv[j] = ((const f32x4*)g)[lane + 64 * j];
    for (int m = gw; m < T; m += ngw) {
        const f32x4* xr = (const f32x4*)(h + (size_t)m * D) + lane;
        f32x4 v[4]; float s = 0.f;
#pragma unroll
        for (int j = 0; j < 4; ++j) { v[j] = xr[64 * j]; s += (v[j][0] * v[j][0] + v[j][1] * v[j][1]) + (v[j][2] * v[j][2] + v[j][3] * v[j][3]); }
        const float rstd = 1.0f / sqrtf(wave_sum(s) * (1.0f / D) + EPS);
        u32x2v* o8 = (u32x2v*)(xn + (size_t)m * D) + lane;
#pragma unroll
        for (int j = 0; j < 4; ++j) { u32x2v w; w.x = pk2(v[j][0] * rstd * gv[j][0], v[j][1] * rstd * gv[j][1]); w.y = pk2(v[j][2] * rstd * gv[j][2], v[j][3] * rstd * gv[j][3]); o8[64 * j] = w; }
    }
}
__device__ __forceinline__ void final_norm_rows(const bf16_t* h, const float* g, float* out, int gw, int ngw, int lane) {
    asm volatile("" : "+v"(lane));
    f32x4 gv[4];
#pragma unroll
    for (int j = 0; j < 4; ++j) gv[j] = ((const f32x4*)g)[lane + 64 * j];
    for (int m0 = gw; m0 < T; m0 += 2 * ngw) {
        const int m1 = (m0 + ngw < T) ? m0 + ngw : m0;
        u32x2v w0[4], w1[4];
#pragma unroll
        for (int j = 0; j < 4; ++j) { w0[j] = ((const u32x2v*)(h + (size_t)m0 * D) + lane)[64 * j]; w1[j] = ((const u32x2v*)(h + (size_t)m1 * D) + lane)[64 * j]; }
#pragma unroll
        for (int rr = 0; rr < 2; ++rr) {
            const int m = rr == 0 ? m0 : m1;
            f32x4 v[4]; float s = 0.f;
#pragma unroll
            for (int j = 0; j < 4; ++j) { const u32x2v w = rr == 0 ? w0[j] : w1[j]; v[j][0] = bflo(w.x); v[j][1] = bfhi(w.x); v[j][2] = bflo(w.y); v[j][3] = bfhi(w.y); s += (v[j][0] * v[j][0] + v[j][1] * v[j][1]) + (v[j][2] * v[j][2] + v[j][3] * v[j][3]); }
            const float rstd = 1.0f / sqrtf(wave_sum(s) * (1.0f / D) + EPS);
            f32x4* o = (f32x4*)(out + (size_t)m * D) + lane;
            if (rr == 0 || m1 != m0) {
#pragma unroll
                for (int j = 0; j < 4; ++j) o[64 * j] = v[j] * rstd * gv[j];
            }
        }
    }
}
__device__ __forceinline__ void convert_p(const float* p, bf16_t* pbf, size_t gtid, size_t gthreads) {
    asm volatile("" : "+v"(gtid));
    const size_t n8 = (size_t)T * PLE / 8;
    for (size_t i = gtid; i < n8; i += gthreads) { const f32x4 a = ((const f32x4*)p)[2 * i], b = ((const f32x4*)p)[2 * i + 1];
        u32x4v w; w.x = pk2(a[0], a[1]); w.y = pk2(a[2], a[3]); w.z = pk2(b[0], b[1]); w.w = pk2(b[2], b[3]); ((u32x4v*)pbf)[i] = w; }
}

#define MFMA16(a, b, c) __builtin_amdgcn_mfma_f32_16x16x32_bf16((a), (b), (c), 0, 0, 0)

#define XB_TMO      128
#define XB_XCNT(j)  (256  + 64 * (j))
#define XB_XSUB(j)  (1280 + 64 * (j))
#define XB_XGEN(j)  (2304 + 64 * (j))
#define XB_TOP      3328
#define XB_TOPGEN   3392
#define XCD_BAR_WORDS 3456
#define XB_SPIN_CAP (1u << 18)

__device__ __forceinline__ unsigned xb_ld(unsigned* p)              { return __hip_atomic_load(p, __ATOMIC_RELAXED, __HIP_MEMORY_SCOPE_AGENT); }
__device__ __forceinline__ unsigned xb_add(unsigned* p, unsigned v) { return __hip_atomic_fetch_add(p, v, __ATOMIC_RELAXED, __HIP_MEMORY_SCOPE_AGENT); }
__device__ __forceinline__ unsigned xb_xcc_id() { return (unsigned)__builtin_amdgcn_s_getreg((3 << 11) | 20) & 0xFu; }
#define XB_SPIN_N(cond, bar, SL) do { unsigned _sp = 0; while (cond) { __builtin_amdgcn_s_sleep(SL); \
    if ((++_sp & 255u) == 0u) { if (xb_ld(&(bar)[XB_TMO])) break; if (_sp > XB_SPIN_CAP) { atomicAdd(&(bar)[XB_TMO], 1u); break; } } } } while (0)
#define XB_SPIN(cond, bar) XB_SPIN_N(cond, bar, 8)
#define XB_SPIN_FAST(cond, bar) XB_SPIN_N(cond, bar, 1)

struct XcdBarrier {
    unsigned* bar; unsigned x;
    volatile LAS unsigned* st;
};

__device__ __forceinline__ XcdBarrier xcd_barrier_post(unsigned* bar, volatile LAS unsigned* st) {
    XcdBarrier b; b.bar = bar; b.x = xb_xcc_id(); b.st = st;
    if (threadIdx.x == 0) (void)xb_add(&bar[XB_XCNT(b.x)], 1u);
    return b;
}
__device__ __forceinline__ void xcd_barrier_complete(unsigned* bar, unsigned x, unsigned& nloc, unsigned& nx) {
    const unsigned G = gridDim.x * gridDim.y * gridDim.z;
    unsigned sum, cnt, mine, sp = 0u;
    for (;;) {
        sum = 0u; cnt = 0u; mine = 0u;
#pragma unroll
        for (unsigned j = 0; j < 16; ++j) { const unsigned c = xb_ld(&bar[XB_XCNT(j)]); sum += c; cnt += (c > 0u) ? 1u : 0u; mine = (j == x) ? c : mine; }
        if (sum == G) break;
        __builtin_amdgcn_s_sleep(1);
        if ((++sp & 255u) == 0u) { if (xb_ld(&bar[XB_TMO])) break; if (sp > XB_SPIN_CAP) { atomicAdd(&bar[XB_TMO], 1u); break; } }
    }
    nloc = mine > 0u ? mine : 1u; nx = cnt > 0u ? cnt : 1u;
}

__device__ __forceinline__ void xcd_barrier(const XcdBarrier& b) {
    asm volatile("s_waitcnt vmcnt(0)" ::: "memory");
    __syncthreads();
    if (threadIdx.x == 0) {
        unsigned* bar = b.bar;
        __builtin_amdgcn_s_waitcnt(0);
        unsigned nloc = b.st[0], nx = b.st[1];
        if (nloc == 0u) { xcd_barrier_complete(bar, b.x, nloc, nx); b.st[0] = nloc; b.st[1] = nx; }
        const unsigned old = xb_add(&bar[XB_XSUB(b.x)], 1u);
        const unsigned gen = old / nloc;
        if (old + 1u == (gen + 1u) * nloc) {
            __builtin_amdgcn_fence(__ATOMIC_RELEASE, "agent");
            asm volatile("s_waitcnt vmcnt(0)" ::: "memory");
            const unsigned og = xb_add(&bar[XB_TOP], 1u);
            const unsigned tg = og / nx;
            if (og + 1u == (tg + 1u) * nx) xb_add(&bar[XB_TOPGEN], 1u);
            else XB_SPIN_FAST(xb_ld(&bar[XB_TOPGEN]) == tg, bar);
            __builtin_amdgcn_fence(__ATOMIC_ACQUIRE, "agent");
            xb_add(&bar[XB_XGEN(b.x)], 1u);
            asm volatile("s_waitcnt vmcnt(0)" ::: "memory");
        } else {
            XB_SPIN(xb_ld(&bar[XB_XGEN(b.x)]) == gen, bar);
            __builtin_amdgcn_fence(__ATOMIC_ACQUIRE, "agent");
            asm volatile("s_waitcnt vmcnt(0)" ::: "memory");
        }
    }
    __syncthreads();
}


__device__ __forceinline__ void mixer_pre_item(int item, const float* const* in, int l, unsigned char* ws, LAS unsigned char* lds, int tid, int lane, int wave) {
    asm volatile("" : "+v"(tid)); lane = tid & 63; wave = __builtin_amdgcn_readfirstlane(tid >> 6);
    const int b = item >> 6, c = item & 63, s0 = c * 32;
    const size_t g0 = (size_t)b * SEQ + s0;
    const bf16_t* U = (const bf16_t*)(ws + WS_R1);
    LAS bf16_t* STGL = (LAS bf16_t*)lds;
    LAS bf16_t* STGD = (LAS bf16_t*)(lds + 17920);
    LAS float* XRF = (LAS float*)(lds + 17920);
    LAS float* AF = (LAS float*)(lds + 50688);
    LAS bf16_t* XRB = (LAS bf16_t*)(lds + 83456);
    __syncthreads();
#pragma unroll
    for (int i = 0; i < 9; ++i) { const int id = tid + 512 * i;
        if (id < 35 * 128) { const int row = id >> 7, pc = id & 127, s = s0 - 3 + row;
            u32x4v v = (u32x4v){0u, 0u, 0u, 0u};
            if (s >= 0) v = *(const u32x4v*)(U + ((size_t)b * SEQ + s) * NIN + (pc < 32 ? pc * 8 : U_DQ + (pc - 32) * 8));
            if (pc < 32) *(LAS u32x4v*)(STGL + row * 256 + pc * 8) = v; else *(LAS u32x4v*)(STGD + row * 768 + (pc - 32) * 8) = v; } }
    __syncthreads();
    for (int task = wave; task < 24; task += 8) {
        const int g = task >> 1, t0 = (task & 1) * 16, kind = g >> 2, hh = g & 3, cc = g * 64 + lane;
        const float* cw = in[17] + (size_t)l * 4 * 768;
        const float w0 = cw[cc], w1 = cw[768 + cc], w2 = cw[1536 + cc], w3 = cw[2304 + cc];
        bf16_t* dst = (bf16_t*)(ws + WS_R2 + (kind == 0 ? R2_DQ : kind == 1 ? R2_DK : R2_DV)) + (g0 + t0) * 256 + hh * 64 + lane;
        float xm3 = bf2f(STGD[t0 * 768 + cc]), xm2 = bf2f(STGD[(t0 + 1) * 768 + cc]), xm1 = bf2f(STGD[(t0 + 2) * 768 + cc]);
        const float qs = (kind == 0) ? 0.125f : 1.0f;
#pragma unroll 8
        for (int t = 0; t < 16; ++t) { const float xc = bf2f(STGD[(t0 + t + 3) * 768 + cc]); float y = siluf_(w0 * xm3 + w1 * xm2 + w2 * xm1 + w3 * xc);
            if (kind < 2) { const float ss = wave_sum(y * y); y *= qs * __builtin_amdgcn_rsqf(ss + EPS); }
            dst[(size_t)t * 256] = f2bf(y);
            xm3 = xm2; xm2 = xm1; xm1 = xc; }
    }
    if (tid < 128) { const int tok = tid >> 2, hh = tid & 3; const float* sd = (const float*)(ws + WS_R2 + R2_DNBA) + (g0 + tok) * 8;
        const float beta = sigmoidf_(sd[hh]), g = -__expf(in[18][l * 4 + hh]) * softplusf_(sd[4 + hh] + in[19][l * 4 + hh]);
        ((float*)(ws + WS_R2 + R2_GG))[(g0 + tok) * 4 + hh] = g; ((float*)(ws + WS_R2 + R2_BE))[(g0 + tok) * 4 + hh] = beta; }
    __syncthreads();
    {
        const int ch = tid & 255, t0 = (tid >> 8) * 16;
        const float* cw = in[8] + (size_t)l * 4 * 256;
        const float w0 = cw[ch], w1 = cw[256 + ch], w2 = cw[512 + ch], w3 = cw[768 + ch], bb = in[9][l * 256 + ch];
        float xm3 = bf2f(STGL[t0 * 256 + ch]), xm2 = bf2f(STGL[(t0 + 1) * 256 + ch]), xm1 = bf2f(STGL[(t0 + 2) * 256 + ch]);
#pragma unroll 8
        for (int i = 0; i < 16; ++i) { const float xc = bf2f(STGL[(t0 + i + 3) * 256 + ch]); const float xr = w0 * xm3 + w1 * xm2 + w2 * xm1 + w3 * xc + bb;
            XRF[(t0 + i) * 256 + ch] = xr; XRB[(t0 + i) * 264 + ch] = f2bf(xr); xm3 = xm2; xm2 = xm1; xm1 = xc; }
    }
    __syncthreads();
    {
        const int hb = wave & 3, mf = wave >> 2, fr = lane & 15, q = lane >> 4;
        const bf16_t* WTa = (const bf16_t*)(ws + WS_W + (size_t)l * W_LAYER + O_LRU) + hb * 4096;
        const bf16_t* WTx = WTa + 16384;
        f32x4 aa[4], ax[4];
#pragma unroll
        for (int nf = 0; nf < 4; ++nf) { aa[nf] = (f32x4){0.f, 0.f, 0.f, 0.f}; ax[nf] = (f32x4){0.f, 0.f, 0.f, 0.f}; }
#pragma unroll
        for (int ks = 0; ks < 2; ++ks) {
            const bf16x8 A = *(const LAS bf16x8*)(XRB + (16 * mf + fr) * 264 + 64 * hb + 32 * ks + 8 * q);
#pragma unroll
            for (int nf = 0; nf < 4; ++nf) {
                const bf16x8 Ba = *(const bf16x8*)(WTa + (16 * nf + fr) * 64 + 32 * ks + 8 * q), Bx = *(const bf16x8*)(WTx + (16 * nf + fr) * 64 + 32 * ks + 8 * q);
                aa[nf] = MFMA16(A, Ba, aa[nf]); ax[nf] = MFMA16(A, Bx, ax[nf]); }
        }
#pragma unroll
        for (int nf = 0; nf < 4; ++nf) {
            const int ch = 64 * hb + 16 * nf + fr;
            const float ba = in[11][l * 256 + ch], bx = in[13][l * 256 + ch], sp = softplusf_(-in[14][l * 256 + ch]);
#pragma unroll
            for (int jj = 0; jj < 4; ++jj) { const int tok = 16 * mf + 4 * q + jj;
                const float r = sigmoidf_(aa[nf][jj] + ba), ig = sigmoidf_(ax[nf][jj] + bx), la = -8.0f * r * sp, a = __expf(la), x2 = 2.0f * la;
                const float om = (x2 > -0.25f) ? -x2 * (1.0f + x2 * (0.5f + x2 * (0.16666667f + x2 * (0.041666668f + x2 * (0.008333334f + x2 * 0.0013888889f))))) : 1.0f - a * a;
                const float mult = sqrtf(om);
                const float xr = XRF[tok * 256 + ch]; AF[tok * 256 + ch] = a; XRF[tok * 256 + ch] = mult * ig * xr; }
        }
    }
    __syncthreads();
    if (tid < 256) {
        float h = 0.f, P = 1.f;
        bf16_t* LH = (bf16_t*)(ws + WS_R2 + R2_LH) + g0 * 256 + tid; bf16_t* PC = (bf16_t*)(ws + WS_R2 + R2_PC) + g0 * 256 + tid;
#pragma unroll 8
        for (int t = 0; t < 32; ++t) { const float a = AF[t * 256 + tid], uu = XRF[t * 256 + tid]; h = a * h + uu; P *= a; LH[t * 256] = f2bf(h); PC[t * 256] = f2bf(P); }
        float2 ag; ag.x = P; ag.y = h; ((float2*)(ws + WS_R2 + R2_AGG))[(size_t)(b * 64 + c) * 256 + tid] = ag;
    }
}

__device__ __forceinline__ void dn_prep_item(int item, unsigned char* ws, LAS unsigned char* lds, int tid, int lane, int wave) {
    asm volatile("" : "+v"(tid)); lane = tid & 63; wave = __builtin_amdgcn_readfirstlane(tid >> 6);
    const int b = item >> 5, c = item & 31;
    const size_t tok0 = (size_t)b * SEQ + c * 64;
    LAS float* LM = (LAS float*)lds;
    LAS float* GC = (LAS float*)(lds + 65536);
    LAS float* BES = (LAS float*)(lds + 65536 + 2048);
    const bf16_t* DQ = (const bf16_t*)(ws + WS_R2 + R2_DQ); const bf16_t* DK = (const bf16_t*)(ws + WS_R2 + R2_DK);
    const bf16_t* DV = (const bf16_t*)(ws + WS_R2 + R2_DV); bf16_t* UUo = (bf16_t*)(ws + WS_UU);
    bf16_t* WW = (bf16_t*)(ws + WS_R2 + R2_WW); bf16_t* QG = (bf16_t*)(ws + WS_R2 + R2_QG); bf16_t* ATT = (bf16_t*)(ws + WS_R2 + R2_ATT); bf16_t* KDT = (bf16_t*)(ws + WS_R2 + R2_KDT);
    const int hd = wave >> 1, half = wave & 1, fr = lane & 15, q = lane >> 4;
    __syncthreads();
    float gc = ((const float*)(ws + WS_R2 + R2_GG))[(tok0 + lane) * 4 + hd];
    const float be_l = ((const float*)(ws + WS_R2 + R2_BE))[(tok0 + lane) * 4 + hd];
    bf16x8 Bk[4][2], Aq[2][2];
#pragma unroll
    for (int cf = 0; cf < 4; ++cf)
#pragma unroll
        for (int ks = 0; ks < 2; ++ks) Bk[cf][ks] = *(const bf16x8*)(DK + (tok0 + 16 * cf + fr) * 256 + hd * 64 + 32 * ks + 8 * q);
    bf16x8 Ak[2][2], Kd[4];
#pragma unroll
    for (int r2 = 0; r2 < 2; ++r2)
#pragma unroll
        for (int ks = 0; ks < 2; ++ks) { Aq[r2][ks] = *(const bf16x8*)(DQ + (tok0 + 16 * (2 * half + r2) + fr) * 256 + hd * 64 + 32 * ks + 8 * q); Ak[r2][ks] = *(const bf16x8*)(DK + (tok0 + 16 * (2 * half + r2) + fr) * 256 + hd * 64 + 32 * ks + 8 * q); }
#pragma unroll
    for (int cf = 0; cf < 4; ++cf) Kd[cf] = *(const bf16x8*)(DK + (tok0 + 16 * cf + fr) * 256 + hd * 64 + 32 * half + 8 * q);
    {
#pragma unroll
        for (int o = 1; o < 64; o <<= 1) { const float t = __shfl_up(gc, o); if (lane >= o) gc += t; }
        const float glast = __shfl(gc, 63);
        GC[wave * 64 + lane] = gc; BES[wave * 64 + lane] = be_l;
        if (half == 0 && lane == 0) ((float*)(ws + WS_R2 + R2_EGL))[(size_t)(b * 32 + c) * 4 + hd] = __expf(glast);
        asm volatile("s_waitcnt lgkmcnt(0)" ::: "memory");
        float gjv[4], giv[2][4], biv[2][4];
#pragma unroll
        for (int cf = 0; cf < 4; ++cf) gjv[cf] = GC[wave * 64 + 16 * cf + fr];
#pragma unroll
        for (int r2 = 0; r2 < 2; ++r2)
#pragma unroll
            for (int jj = 0; jj < 4; ++jj) { const int i = 16 * (2 * half + r2) + 4 * q + jj; giv[r2][jj] = GC[wave * 64 + i]; biv[r2][jj] = BES[wave * 64 + i]; }
        const float sc_q0 = __expf(GC[wave * 64 + 16 * (2 * half) + fr]), sc_q1 = __expf(GC[wave * 64 + 16 * (2 * half + 1) + fr]);
#pragma unroll
        for (int r2 = 0; r2 < 2; ++r2) { const int rf = 2 * half + r2;
#pragma unroll
            for (int cf = 0; cf < 4; ++cf) {
                f32x4 kk = (f32x4){0.f, 0.f, 0.f, 0.f}, qk = (f32x4){0.f, 0.f, 0.f, 0.f};
#pragma unroll
                for (int ks = 0; ks < 2; ++ks) { kk = MFMA16(Ak[r2][ks], Bk[cf][ks], kk); qk = MFMA16(Aq[r2][ks], Bk[cf][ks], qk); }
                const int j = 16 * cf + fr; const float gj = gjv[cf];
#pragma unroll
                for (int jj = 0; jj < 4; ++jj) { const int i = 16 * rf + 4 * q + jj; const float gi = giv[r2][jj], bi = biv[r2][jj];
                    const float dec = (j <= i) ? __expf(gi - gj) : 0.f;
                    LM[(hd * 64 + i) * 64 + j] = (j < i) ? bi * kk[jj] * dec : 0.f;
                    ATT[(tok0 + i) * 256 + hd * 64 + j] = f2bf(qk[jj] * dec); }
            }
        }
#pragma unroll
        for (int r2 = 0; r2 < 2; ++r2) { const int iq = 16 * (2 * half + r2) + fr; const float sc = r2 == 0 ? sc_q0 : sc_q1;
#pragma unroll
            for (int ks = 0; ks < 2; ++ks) { const u32x4v w = __builtin_bit_cast(u32x4v, Aq[r2][ks]);
                u32x4v r; r.x = pk2(bflo(w.x) * sc, bfhi(w.x) * sc); r.y = pk2(bflo(w.y) * sc, bfhi(w.y) * sc); r.z = pk2(bflo(w.z) * sc, bfhi(w.z) * sc); r.w = pk2(bflo(w.w) * sc, bfhi(w.w) * sc);
                *(u32x4v*)(QG + (tok0 + iq) * 256 + hd * 64 + 32 * ks + 8 * q) = r; } }
#pragma unroll
        for (int cf = 0; cf < 4; ++cf) { const int cj = 16 * cf + fr; const float sc = __expf(glast - gjv[cf]);
            const u32x4v w = __builtin_bit_cast(u32x4v, Kd[cf]);
            bf16_t* dp = KDT + (tok0 + 32 * half + 8 * q) * 256 + hd * 64 + cj;
            dp[0 * 256] = f2bf(bflo(w.x) * sc); dp[1 * 256] = f2bf(bfhi(w.x) * sc); dp[2 * 256] = f2bf(bflo(w.y) * sc); dp[3 * 256] = f2bf(bfhi(w.y) * sc);
            dp[4 * 256] = f2bf(bflo(w.z) * sc); dp[5 * 256] = f2bf(bfhi(w.z) * sc); dp[6 * 256] = f2bf(bflo(w.w) * sc); dp[7 * 256] = f2bf(bfhi(w.w) * sc); }
    }
    unsigned short xr[64];
    { const bf16_t* src = (half == 0 ? DV : DK) + tok0 * 256 + hd * 64 + lane;
#pragma unroll
      for (int i = 0; i < 64; ++i) xr[i] = src[(size_t)i * 256]; }
    __syncthreads();
    {
        const int col = lane;
        float x[64];
#ifdef PROBE_PHB
        for (int rep_ = 0; rep_ < PROBE_PHB; ++rep_) { asm volatile("" ::: "memory");
#endif
        const LAS float* bes = BES + (hd * 2) * 64; const LAS float* gcs = GC + (hd * 2) * 64;
        if (half == 0) {
#pragma unroll
            for (int i = 0; i < 64; ++i) x[i] = bf2f(xr[i]) * bes[i];
        } else {
#pragma unroll
            for (int i = 0; i < 64; ++i) x[i] = bf2f(xr[i]) * bes[i] * __expf(gcs[i]);
        }
        const LAS float* Lh = LM + hd * 4096;
#pragma unroll
        for (int i = 1; i < 64; ++i) {
            float acc = x[i];
#pragma unroll
            for (int j4 = 0; j4 < (i + 3) / 4; ++j4) { const f32x4 lv = *(const LAS f32x4*)(Lh + i * 64 + 4 * j4);
#pragma unroll
                for (int jj = 0; jj < 4; ++jj) if (4 * j4 + jj < i) acc -= lv[jj] * x[4 * j4 + jj]; }
            x[i] = acc;
        }
#ifdef PROBE_PHB
        asm volatile("" : "+v"(x[63])); }
#endif
        if (half == 0) {
#pragma unroll
            for (int i = 0; i < 64; ++i) UUo[(tok0 + i) * 256 + hd * 64 + col] = f2bf(x[i]);
        } else {
#pragma unroll
            for (int i = 0; i < 64; ++i) WW[(tok0 + i) * 256 + hd * 64 + col] = f2bf(x[i]);
        }
    }
}
__device__ __forceinline__ void dn_chain_item(int item, const float* const* in, int l, unsigned char* ws, bf16_t* ybuf, LAS unsigned char* lds, int tid, int lane, int wave) {
    asm volatile("" : "+v"(tid)); lane = tid & 63; wave = __builtin_amdgcn_readfirstlane(tid >> 6);
    const int b = item >> 2, hd = item & 3;
    LAS bf16_t* Wl = (LAS bf16_t*)lds; LAS bf16_t* QGl = Wl + 64 * 72; LAS bf16_t* ATl = QGl + 64 * 72; LAS bf16_t* KDl = ATl + 64 * 72;
    LAS bf16_t* UUl = (LAS bf16_t*)(lds + 36864); LAS float* OSl = (LAS float*)(lds + 53248);
    const bf16_t* WW = (const bf16_t*)(ws + WS_R2 + R2_WW); const bf16_t* QG = (const bf16_t*)(ws + WS_R2 + R2_QG); const bf16_t* ATT = (const bf16_t*)(ws + WS_R2 + R2_ATT); const bf16_t* KDT = (const bf16_t*)(ws + WS_R2 + R2_KDT);
    const bf16_t* UUg = (const bf16_t*)(ws + WS_UU); const float* EGL = (const float*)(ws + WS_R2 + R2_EGL);
    const bf16_t* U = (const bf16_t*)(ws + WS_R1); bf16_t* Y = ybuf;
    const int lr = tid >> 3, lp = tid & 7, fr = lane & 15, q = lane >> 4, ef = wave;
    const int orow = (tid & 255) >> 2, op = tid & 3;
    const size_t base = (size_t)b * SEQ * 256 + hd * 64;
    f32x4 Sacc[4];
#pragma unroll
    for (int df = 0; df < 4; ++df) Sacc[df] = (f32x4){0.f, 0.f, 0.f, 0.f};
    u32x4v rwA, rqA, raA, rkA, ruA, rz0A, rz1A, rwB, rqB, raB, rkB, ruB, rz0B, rz1B, pz0, pz1;
    rz0A = (u32x4v){0u, 0u, 0u, 0u}; rz1A = rz0A; rz0B = rz0A; rz1B = rz0A;
    pz0 = (u32x4v){0u, 0u, 0u, 0u}; pz1 = pz0;
#define DN_LOAD(cc, S) do { const size_t o = base + (size_t)((cc) * 64 + lr) * 256 + lp * 8; rw##S = *(const u32x4v*)(WW + o); rq##S = *(const u32x4v*)(QG + o); ra##S = *(const u32x4v*)(ATT + o); rk##S = *(const u32x4v*)(KDT + o); \
        ru##S = *(const u32x4v*)(UUg + o); \
        if (wave >= 4) { const bf16_t* zp = U + ((size_t)b * SEQ + (cc) * 64 + orow) * NIN + U_DZ + hd * 64 + op * 16; rz0##S = *(const u32x4v*)zp; rz1##S = *(const u32x4v*)(zp + 8); } } while (0)
#define DN_OUT(cc, zA, zB) do { const LAS float* os = OSl + ((cc) & 1) * 4096 + orow * 64 + op * 16; const f32x4 o0 = *(const LAS f32x4*)os, o1 = *(const LAS f32x4*)(os + 4), o2 = *(const LAS f32x4*)(os + 8), o3 = *(const LAS f32x4*)(os + 12); \
        float ss = (o0[0] * o0[0] + o0[1] * o0[1]) + (o0[2] * o0[2] + o0[3] * o0[3]) + (o1[0] * o1[0] + o1[1] * o1[1]) + (o1[2] * o1[2] + o1[3] * o1[3]) + (o2[0] * o2[0] + o2[1] * o2[1]) + (o2[2] * o2[2] + o2[3] * o2[3]) + (o3[0] * o3[0] + o3[1] * o3[1]) + (o3[2] * o3[2] + o3[3] * o3[3]); \
        ss += __shfl_xor(ss, 1); ss += __shfl_xor(ss, 2); \
        const float rs = 1.0f / sqrtf(ss * (1.0f / 64.0f) + EPS); \
        const f32x4 n0 = nwA * rs, n1 = nwB * rs, n2 = nwC * rs, n3 = nwD * rs; \
        u32x4v w0, w1; \
        w0.x = pk2(o0[0] * n0[0] * siluf_(bflo(zA.x)), o0[1] * n0[1] * siluf_(bfhi(zA.x))); w0.y = pk2(o0[2] * n0[2] * siluf_(bflo(zA.y)), o0[3] * n0[3] * siluf_(bfhi(zA.y))); \
        w0.z = pk2(o1[0] * n1[0] * siluf_(bflo(zA.z)), o1[1] * n1[1] * siluf_(bfhi(zA.z))); w0.w = pk2(o1[2] * n1[2] * siluf_(bflo(zA.w)), o1[3] * n1[3] * siluf_(bfhi(zA.w))); \
        w1.x = pk2(o2[0] * n2[0] * siluf_(bflo(zB.x)), o2[1] * n2[1] * siluf_(bfhi(zB.x))); w1.y = pk2(o2[2] * n2[2] * siluf_(bflo(zB.y)), o2[3] * n2[3] * siluf_(bfhi(zB.y))); \
        w1.z = pk2(o3[0] * n3[0] * siluf_(bflo(zB.z)), o3[1] * n3[1] * siluf_(bfhi(zB.z))); w1.w = pk2(o3[2] * n3[2] * siluf_(bflo(zB.w)), o3[3] * n3[3] * siluf_(bfhi(zB.w))); \
        bf16_t* yp = Y + ((size_t)b * SEQ + (cc) * 64 + orow) * D + 768 + hd * 64 + op * 16; *(u32x4v*)yp = w0; *(u32x4v*)(yp + 8) = w1; } while (0)
    const float* nwp = in[20] + l * 64 + op * 16; const f32x4 nwA = *(const f32x4*)nwp, nwB = *(const f32x4*)(nwp + 4), nwC = *(const f32x4*)(nwp + 8), nwD = *(const f32x4*)(nwp + 12);
#define DN_FRAG(P, row, s) ({ const LAS bf16_t* _p = (P) + (row) * 72 + 32 * (s) + 4 * q; const u32x2v _lo = *(const LAS u32x2v*)_p, _hi = *(const LAS u32x2v*)(_p + 16); u32x4v _w; _w.x = _lo.x; _w.y = _lo.y; _w.z = _hi.x; _w.w = _hi.y; __builtin_bit_cast(bf16x8, _w); })
#define DN_BODY(c, S) do { \
        *(LAS u32x4v*)(Wl + lr * 72 + lp * 8) = rw##S; *(LAS u32x4v*)(QGl + lr * 72 + lp * 8) = rq##S; *(LAS u32x4v*)(ATl + lr * 72 + lp * 8) = ra##S; *(LAS u32x4v*)(KDl + lr * 72 + lp * 8) = rk##S; \
        *(LAS u32x4v*)(UUl + lr * 72 + lp * 8) = ru##S; \
        const u32x4v cz0 = pz0, cz1 = pz1; \
        pz0 = rz0##S; pz1 = rz1##S; \
        const float egl = egl_n; egl_n = EGL[(size_t)(b * 32 + (c + 1 < 32 ? c + 1 : c)) * 4 + hd]; \
        __syncthreads(); \
        if (c + 2 < 32) DN_LOAD(c + 2, S); \
        if (wave < 4) { \
            LAS float* OSc = OSl + (c & 1) * 4096; \
            bf16x8 fr_[4][2]; float uu[4][4]; \
            bf16x8 Sb[2], Vb[2]; \
_Pragma("unroll") \
            for (int s = 0; s < 2; ++s) { u32x4v w; w.x = pk2(Sacc[2 * s][0], Sacc[2 * s][1]); w.y = pk2(Sacc[2 * s][2], Sacc[2 * s][3]); w.z = pk2(Sacc[2 * s + 1][0], Sacc[2 * s + 1][1]); w.w = pk2(Sacc[2 * s + 1][2], Sacc[2 * s + 1][3]); Sb[s] = __builtin_bit_cast(bf16x8, w); } \
            f32x4 vn[4], oo[4]; \
_Pragma("unroll") \
            for (int cf = 0; cf < 4; ++cf) \
_Pragma("unroll") \
                for (int s = 0; s < 2; ++s) fr_[cf][s] = DN_FRAG(Wl, 16 * cf + fr, s); \
_Pragma("unroll") \
            for (int cf = 0; cf < 4; ++cf) \
_Pragma("unroll") \
                for (int jj = 0; jj < 4; ++jj) uu[cf][jj] = bf2f(UUl[(16 * cf + 4 * q + jj) * 72 + 16 * ef + fr]); \
_Pragma("unroll") \
            for (int cf = 0; cf < 4; ++cf) { f32x4 a = (f32x4){0.f, 0.f, 0.f, 0.f}; a = MFMA16(fr_[cf][0], Sb[0], a); a = MFMA16(fr_[cf][1], Sb[1], a); vn[cf] = a; } \
_Pragma("unroll") \
            for (int cf = 0; cf < 4; ++cf) \
_Pragma("unroll") \
                for (int s = 0; s < 2; ++s) fr_[cf][s] = DN_FRAG(QGl, 16 * cf + fr, s); \
_Pragma("unroll") \
            for (int cf = 0; cf < 4; ++cf) { f32x4 a = (f32x4){0.f, 0.f, 0.f, 0.f}; a = MFMA16(fr_[cf][0], Sb[0], a); a = MFMA16(fr_[cf][1], Sb[1], a); oo[cf] = a; } \
_Pragma("unroll") \
            for (int cf = 0; cf < 4; ++cf) \
_Pragma("unroll") \
                for (int s = 0; s < 2; ++s) if (32 * s <= 16 * cf + 15) fr_[cf][s] = DN_FRAG(ATl, 16 * cf + fr, s); \
_Pragma("unroll") \
            for (int cf = 0; cf < 4; ++cf) \
_Pragma("unroll") \
                for (int jj = 0; jj < 4; ++jj) vn[cf][jj] = uu[cf][jj] - vn[cf][jj]; \
_Pragma("unroll") \
            for (int s = 0; s < 2; ++s) { u32x4v w; w.x = pk2(vn[2 * s][0], vn[2 * s][1]); w.y = pk2(vn[2 * s][2], vn[2 * s][3]); w.z = pk2(vn[2 * s + 1][0], vn[2 * s + 1][1]); w.w = pk2(vn[2 * s + 1][2], vn[2 * s + 1][3]); Vb[s] = __builtin_bit_cast(bf16x8, w); } \
_Pragma("unroll") \
            for (int cf = 0; cf < 4; ++cf) \
_Pragma("unroll") \
                for (int s = 0; s < 2; ++s) if (32 * s <= 16 * cf + 15) oo[cf] = MFMA16(fr_[cf][s], Vb[s], oo[cf]); \
_Pragma("unroll") \
            for (int cf = 0; cf < 4; ++cf) \
_Pragma("unroll") \
                for (int s = 0; s < 2; ++s) fr_[cf][s] = DN_FRAG(KDl, 16 * cf + fr, s); \
_Pragma("unroll") \
            for (int df = 0; df < 4; ++df) { f32x4 a = Sacc[df] * egl; a = MFMA16(fr_[df][0], Vb[0], a); a = MFMA16(fr_[df][1], Vb[1], a); Sacc[df] = a; } \
_Pragma("unroll") \
            for (int cf = 0; cf < 4; ++cf) \
_Pragma("unroll") \
                for (int jj = 0; jj < 4; ++jj) OSc[(16 * cf + 4 * q + jj) * 64 + 16 * ef + fr] = oo[cf][jj]; \
        } else if (c > 0) { DN_OUT(c - 1, cz0, cz1); } \
        __syncthreads(); \
    } while (0)
    DN_LOAD(0, A); DN_LOAD(1, B);
    float egl_n = EGL[(size_t)(b * 32) * 4 + hd];
    __syncthreads();
    for (int c2 = 0; c2 < 32; c2 += 2) { DN_BODY(c2, A); DN_BODY(c2 + 1, B); }
    if (wave >= 4) { DN_OUT(31, pz0, pz1); }
    __syncthreads();
#undef DN_LOAD
#undef DN_BODY
#undef DN_OUT
#undef DN_FRAG
}
__device__ __forceinline__ void lru_carry_item(int b, unsigned char* ws, int tid) {
    asm volatile("" : "+v"(tid));
    if (tid < 256) {
        const float2* AGG = (const float2*)(ws + WS_R2 + R2_AGG) + (size_t)b * 64 * 256 + tid;
        float* CARRY = (float*)(ws + WS_R2 + R2_CARRY) + (size_t)b * 64 * 256 + tid;
        float carry = 0.f;
#pragma unroll
        for (int h = 0; h < 2; ++h) {
            float2 ag[32];
#pragma unroll
            for (int k = 0; k < 32; ++k) ag[k] = AGG[(h * 32 + k) * 256];
#pragma unroll
            for (int k = 0; k < 32; ++k) { CARRY[(h * 32 + k) * 256] = carry; carry = ag[k].x * carry + ag[k].y; }
        }
    }
}
__device__ __forceinline__ void lru_fix_item(int item, unsigned char* ws, bf16_t* ybuf, int tid) {
    asm volatile("" : "+v"(tid));
    const int b = item >> 6, c = item & 63, cv = (tid & 31) * 8;
    const float* cp = (const float*)(ws + WS_R2 + R2_CARRY) + (size_t)(b * 64 + c) * 256 + cv;
    const f32x4 ca = *(const f32x4*)cp, cb = *(const f32x4*)(cp + 4);
    u32x4v lh[2], pc[2], gt_[2];
#pragma unroll
    for (int j = 0; j < 2; ++j) { const size_t gt = (size_t)b * SEQ + c * 32 + (tid >> 5) + 16 * j;
        lh[j] = *(const u32x4v*)((const bf16_t*)(ws + WS_R2 + R2_LH) + gt * 256 + cv); pc[j] = *(const u32x4v*)((const bf16_t*)(ws + WS_R2 + R2_PC) + gt * 256 + cv);
        gt_[j] = *(const u32x4v*)((const bf16_t*)(ws + WS_R1) + gt * NIN + U_LRUG + cv); }
#pragma unroll
    for (int j = 0; j < 2; ++j) { const size_t gt = (size_t)b * SEQ + c * 32 + (tid >> 5) + 16 * j;
        u32x4v o;
        o.x = pk2(gelu_tanh(bflo(gt_[j].x)) * (bflo(lh[j].x) + bflo(pc[j].x) * ca[0]), gelu_tanh(bfhi(gt_[j].x)) * (bfhi(lh[j].x) + bfhi(pc[j].x) * ca[1]));
        o.y = pk2(gelu_tanh(bflo(gt_[j].y)) * (bflo(lh[j].y) + bflo(pc[j].y) * ca[2]), gelu_tanh(bfhi(gt_[j].y)) * (bfhi(lh[j].y) + bfhi(pc[j].y) * ca[3]));
        o.z = pk2(gelu_tanh(bflo(gt_[j].z)) * (bflo(lh[j].z) + bflo(pc[j].z) * cb[0]), gelu_tanh(bfhi(gt_[j].z)) * (bfhi(lh[j].z) + bfhi(pc[j].z) * cb[1]));
        o.w = pk2(gelu_tanh(bflo(gt_[j].w)) * (bflo(lh[j].w) + bflo(pc[j].w) * cb[2]), gelu_tanh(bfhi(gt_[j].w)) * (bfhi(lh[j].w) + bfhi(pc[j].w) * cb[3]));
        *(u32x4v*)(ybuf + gt * D + cv) = o; }
}
constexpr int ATT_BT_OFF = 102400;
constexpr int ATT_CT_OFF = 73728;
__device__ __forceinline__ void attn_item(int item, const float* const* in, int l, unsigned char* ws, bf16_t* ybuf, LAS unsigned char* lds, int tid, int lane, int wave) {
    asm volatile("" : "+v"(tid)); lane = tid & 63; wave = __builtin_amdgcn_readfirstlane(tid >> 6);
    const int kh = item & 1, nb = (item >> 1) & 15, b = item >> 5;
    LAS bf16_t* KL = (LAS bf16_t*)lds;
    LAS bf16_t* VT = (LAS bf16_t*)(lds + 36864);
    const LAS float* BT = (const LAS float*)(lds + ATT_BT_OFF);
    LAS float* CT = (LAS float*)(lds + ATT_CT_OFF);
    const bf16_t* U = (const bf16_t*)(ws + WS_R1);
    bf16_t* Y = ybuf;
    const int hl = wave >> 1, hq = kh * 4 + hl, qhalf = wave & 1, fr = lane & 15, q = lane >> 4;
    bf16x8 Bq[4][2];
#pragma unroll
    for (int qg = 0; qg < 4; ++qg) { const bf16_t* qp = U + ((size_t)b * SEQ + nb * 128 + qhalf * 64 + qg * 16 + fr) * NIN + U_AQ + hq * 64 + 8 * q; Bq[qg][0] = *(const bf16x8*)qp; Bq[qg][1] = *(const bf16x8*)(qp + 32); }
    __syncthreads();
#pragma unroll
    for (int i = 0; i < 4; ++i) { const int key = tid & 255, part = (tid >> 8) + 2 * i, pos = (nb - 1) * 128 + key;
        u32x4v kv = (u32x4v){0u, 0u, 0u, 0u}, vv = (u32x4v){0u, 0u, 0u, 0u};
        if (pos >= 0) { const bf16_t* src = U + ((size_t)b * SEQ + pos) * NIN; kv = *(const u32x4v*)(src + 1024 + kh * 64 + part * 8); vv = *(const u32x4v*)(src + 1152 + kh * 64 + part * 8); }
        *(LAS u32x4v*)(KL + key * 72 + part * 8) = kv;
        LAS bf16_t* vd = VT + (part * 8) * 272 + key;
        vd[0] = (bf16_t)(vv.x & 0xffffu); vd[272] = (bf16_t)(vv.x >> 16); vd[2 * 272] = (bf16_t)(vv.y & 0xffffu); vd[3 * 272] = (bf16_t)(vv.y >> 16);
        vd[4 * 272] = (bf16_t)(vv.z & 0xffffu); vd[5 * 272] = (bf16_t)(vv.z >> 16); vd[6 * 272] = (bf16_t)(vv.w & 0xffffu); vd[7 * 272] = (bf16_t)(vv.w >> 16); }
    const float NEG_INF = -__builtin_inff();
    for (int e = tid; e < 4 * 4 * 384; e += NTHR) { const int h = e / 1536, r = e % 1536, sft = r / 384, x = (r % 384) - 128 + sft;
        CT[e] = (x >= 0 && x <= 127) ? BT[(kh * 4 + h) * 128 + (127 - x)] : NEG_INF; }
    __syncthreads();
    const float sink = in[15][l * 8 + hq];
#pragma unroll
    for (int qg = 0; qg < 4; ++qg) {
        const int i0 = qhalf * 64 + qg * 16, iq = i0 + fr, s_lo = 2 * qhalf + (qg >> 1);
        const size_t gt = (size_t)b * SEQ + nb * 128 + iq;
        const bf16x8 Bq0 = Bq[qg][0], Bq1 = Bq[qg][1];
        f32x4 acc[10];
#pragma unroll
        for (int r = 0; r < 10; ++r) { const LAS bf16_t* kp = KL + (16 * (2 * s_lo + r) + fr) * 72 + 8 * q;
            f32x4 a = (f32x4){0.f, 0.f, 0.f, 0.f}; a = MFMA16(*(const LAS bf16x8*)kp, Bq0, a); a = MFMA16(*(const LAS bf16x8*)(kp + 32), Bq1, a); acc[r] = a; }
        const int a1 = iq + 1, sft = (4 - (a1 & 3)) & 3, a4 = (a1 + sft) >> 2;
        const LAS float* ct = CT + (hl * 4 + sft) * 384 + 128 + 4 * (4 * (2 * s_lo) + q - a4);
        float mx = sink;
#pragma unroll
        for (int r = 0; r < 10; ++r) { const f32x4 tb = *(const LAS f32x4*)(ct + 16 * r); const bool dead = (nb == 0) && (2 * s_lo + r < 8);
#pragma unroll
            for (int jj = 0; jj < 4; ++jj) { float sc = acc[r][jj] * 0.125f + tb[jj]; sc = dead ? NEG_INF : sc; acc[r][jj] = sc; mx = fmaxf(mx, sc); } }
        mx = fmaxf(mx, __shfl_xor(mx, 16)); mx = fmaxf(mx, __shfl_xor(mx, 32));
        float sum = 0.f;
#pragma unroll
        for (int r = 0; r < 10; ++r)
#pragma unroll
            for (int jj = 0; jj < 4; ++jj) { const float ev = __expf(acc[r][jj] - mx); acc[r][jj] = ev; sum += ev; }
        sum += __shfl_xor(sum, 16); sum += __shfl_xor(sum, 32);
        const float inv = 1.0f / (sum + __expf(sink - mx));
        f32x4 o[4];
#pragma unroll
        for (int df = 0; df < 4; ++df) o[df] = (f32x4){0.f, 0.f, 0.f, 0.f};
#pragma unroll
        for (int s = 0; s < 5; ++s) {
            u32x4v pw; pw.x = pk2(acc[2 * s][0], acc[2 * s][1]); pw.y = pk2(acc[2 * s][2], acc[2 * s][3]); pw.z = pk2(acc[2 * s + 1][0], acc[2 * s + 1][1]); pw.w = pk2(acc[2 * s + 1][2], acc[2 * s + 1][3]);
            const bf16x8 P = __builtin_bit_cast(bf16x8, pw);
#pragma unroll
            for (int df = 0; df < 4; ++df) { const LAS bf16_t* vp = VT + (16 * df + fr) * 272 + 32 * (s_lo + s) + 4 * q;
                const u32x2v lo = *(const LAS u32x2v*)vp, hi = *(const LAS u32x2v*)(vp + 16);
                u32x4v aw; aw.x = lo.x; aw.y = lo.y; aw.z = hi.x; aw.w = hi.y;
                o[df] = MFMA16(__builtin_bit_cast(bf16x8, aw), P, o[df]); }
        }
#pragma unroll
        for (int df = 0; df < 4; ++df) { u32x2v w; w.x = pk2(o[df][0] * inv, o[df][1] * inv); w.y = pk2(o[df][2] * inv, o[df][3] * inv);
            *(u32x2v*)(Y + gt * D + 256 + hq * 64 + 16 * df + 4 * q) = w; }
    }
}
__device__ __forceinline__ void attn_bias_table(const float* rel_bias, LAS unsigned char* lds, int tid) {
    LAS float* BT = (LAS float*)(lds + ATT_BT_OFF);
    for (int idx = tid; idx < 1024; idx += NTHR) { const int h = idx >> 7, dist = idx & 127;
        int bucket = dist;
        if (dist >= 16) bucket = 16 + (dist >= 19) + (dist >= 21) + (dist >= 24) + (dist >= 27) + (dist >= 31) + (dist >= 35) + (dist >= 40) + (dist >= 46) + (dist >= 52) + (dist >= 59) + (dist >= 67) + (dist >= 77) + (dist >= 87) + (dist >= 99) + (dist >= 113);
        BT[idx] = rel_bias[bucket * 8 + h]; }
}

constexpr int LDS_CTL_OFF = 147456 - 256;
#ifndef PROBE_PRE
#define PROBE_PRE 1
#endif
#ifndef PROBE_PREP
#define PROBE_PREP 1
#endif
#ifndef PROBE_P0
#define PROBE_P0 1
#endif
#ifndef PROBE_G1
#define PROBE_G1 1
#endif
#ifndef ATT_IN_PREP
#define ATT_IN_PREP 512
#endif
#ifndef GEMM_SP2
#define GEMM_SP2 true
#endif
#ifndef PROBE_G2
#define PROBE_G2 1
#endif
#ifndef REV_DOWN
#define REV_DOWN 0
#endif
#ifndef PROBE_G3
#define PROBE_G3 1
#endif
#ifndef CONV_LATE
#define CONV_LATE 0
#endif
#ifndef PROBE_LRUFIX
#define PROBE_LRUFIX 1
#endif
#ifndef PROBE_MAIN
#define PROBE_MAIN 1
#endif
#ifndef PROBE_SYNC
#define PROBE_SYNC 0
#endif
struct Args { const float* in[30]; float* out; unsigned char* ws; };
template <class Epi>
__device__ __forceinline__ void run_gemm(LAS unsigned char* lds, const bf16_t* A, const bf16_t* Bt, int N, int K, const Epi& E, int rev = 0, int gsz = 0, int grank = 0) {
    asm volatile("" : "+s"(K), "+s"(N));
    pg8::Gemm g{A, Bt, T, N, K}; pg8::StaticOrder S; S.init(T, N, gsz > 0 ? gsz : (int)gridDim.x, gsz > 0 ? grank : (int)blockIdx.x, rev);
    pg8::gemm_phase<Epi, pg8::StaticOrder, true, GEMM_SP2>(lds, g, S, E);
}
__global__ void __launch_bounds__(NTHR, 2) hymba_fwd(Args args) {
    extern __shared__ __attribute__((aligned(16))) unsigned char lds_raw[];
    LAS unsigned char* lds = (LAS unsigned char*)lds_raw;
    cg::grid_group grid = cg::this_grid();
    const int tid = threadIdx.x, lane = tid & 63, wave = __builtin_amdgcn_readfirstlane(tid >> 6);
    const int G = gridDim.x, bid = blockIdx.x;
    const int gw = bid * NWAVES + wave, ngw = G * NWAVES;
    const float* const* in = args.in;
    unsigned char* ws = args.ws;
    float* out = args.out;
    bf16_t* R1 = (bf16_t*)(ws + WS_R1);
    bf16_t* PBF = (bf16_t*)(ws + WS_R2 + R2_PBF);
    bf16_t* PBUF = (bf16_t*)(ws + WS_R2 + R2_PBUF);
    float* DNBA = (float*)(ws + WS_R2 + R2_DNBA);

    bf16_t* XA = (bf16_t*)(ws + WS_XN);
    bf16_t* YB = (bf16_t*)out;
    bf16_t* XB = (bf16_t*)(ws + WS_R2 + R2_XB);
    float* RSS = (float*)(ws + WS_RSS);
    if (bid == 0) for (int i = tid; i < XCD_BAR_WORDS; i += NTHR) ((unsigned*)ws)[i] = 0u;
    if (tid < 2) ((LAS unsigned*)(lds + LDS_CTL_OFF))[tid] = 0u;
    for (int rep = 0; rep < PROBE_P0; ++rep) {
    convert_weights(in, ws, (LAS float*)(lds + wave * 16384), gw, ngw, lane, 0, NL * CONV_PER_LAYER - CONV_LATE);
    rows_bf16_sumsq(in[0], XA, RSS, gw, ngw, lane);
    }
    grid.sync();
    const XcdBarrier xbar = xcd_barrier_post((unsigned*)ws, (volatile LAS unsigned*)(lds + LDS_CTL_OFF));
#define GSYNC() xcd_barrier(xbar)

    for (int l = 0; l < NL; ++l) {
        const unsigned char* wl = ws + WS_W + (size_t)l * W_LAYER;
        int tid = threadIdx.x; asm volatile("" : "+v"(tid)); int lane = tid & 63;
        const bf16_t* hin = (l == 0) ? XA : XB;
        float* rss0 = RSS, *rss1 = RSS + (size_t)4 * T, *rss2 = RSS, *rss3 = RSS + (size_t)4 * T, *rss4 = RSS;
        LAS float* part = (LAS float*)(lds + EPI_LDS_OFF);
        for (int rep = 0; rep < PROBE_G1; ++rep) {
        { EpiSwiglu E{R1, rss0}; run_gemm(lds, l == 0 ? XA : XB, (const bf16_t*)(wl + O_GU1), 2 * FF, D, E); }
        GSYNC();
        }
        for (int rep = 1; rep < (l == 0 ? PROBE_G2 : 1); ++rep) {
        { EpiResid E{hin, XB, 0.5f, rss1, part}; run_gemm(lds, R1, (const bf16_t*)(wl + O_D1), D, FF, E, REV_DOWN); }
        GSYNC();
        }
        { EpiResid E{hin, XA, 0.5f, rss1, part}; run_gemm(lds, R1, (const bf16_t*)(wl + O_D1), D, FF, E, REV_DOWN); }
        GSYNC();
        for (int rep = 0; rep < PROBE_G3; ++rep) {
        { EpiBf16<NIN, true> E{R1, DNBA, rss1}; run_gemm(lds, XA, (const bf16_t*)(wl + O_IN), NIN, D, E); }
        GSYNC();
        }
        for (int rep = 0; rep < PROBE_PRE; ++rep) {
        for (int it = bid; it < NBATCH * 64; it += G) mixer_pre_item(it, in, l, ws, lds, tid, lane, wave);
        { int t_ = threadIdx.x; asm volatile("" : "+v"(t_)); convert_p(in[1] + (size_t)l * T * PLE, PBF, (size_t)bid * NTHR + t_, (size_t)G * NTHR); }
        GSYNC();
        }
        for (int rep = 0; rep < PROBE_PREP; ++rep) {
            attn_bias_table(in[16], lds, tid);
            for (int b2 = G - 1 - bid; b2 < NBATCH; b2 += G) lru_carry_item(b2, ws, tid);
            for (int it = bid; it < NBATCH * 32; it += G) dn_prep_item(it, ws, lds, tid, lane, wave);
            for (int it = bid; it < ATT_IN_PREP; it += G) attn_item(511 - it, in, l, ws, YB, lds, tid, lane, wave);
            GSYNC();
        }
        for (int rep = 0; rep < PROBE_MAIN; ++rep) {
            if (ATT_IN_PREP < 512) { attn_bias_table(in[16], lds, tid); __syncthreads(); }
            if (G >= 128) {
                if (bid < 64) dn_chain_item(bid, in, l, ws, YB, lds, tid, lane, wave);
                else { const int r = bid - 64, R = G - 64;
                    for (int it = r; it < 512 - ATT_IN_PREP; it += R) attn_item(it, in, l, ws, YB, lds, tid, lane, wave);
                    for (int rep2 = 0; rep2 < PROBE_LRUFIX; ++rep2)
                    for (int it = r; it < NBATCH * 64; it += R) lru_fix_item(it, ws, YB, tid);
                    { __syncthreads(); EpiBf16<D, false> E{PBUF, nullptr, nullptr}; run_gemm(lds, PBF, (const bf16_t*)(wl + O_PP), D, PLE, E, 0, R, r); }
                    if (l == 0 && CONV_LATE > 0) { __syncthreads(); convert_weights(in, ws, (LAS float*)(lds + wave * 16384), r * NWAVES + wave, R * NWAVES, lane, NL * CONV_PER_LAYER - CONV_LATE, NL * CONV_PER_LAYER); }
                }
            } else {
                for (int it = bid; it < 64; it += G) dn_chain_item(it, in, l, ws, YB, lds, tid, lane, wave);
                attn_bias_table(in[16], lds, tid);
                for (int it = bid; it < 512 - ATT_IN_PREP; it += G) attn_item(it, in, l, ws, YB, lds, tid, lane, wave);
                for (int it = bid; it < NBATCH * 64; it += G) lru_fix_item(it, ws, YB, tid);
                { __syncthreads(); EpiBf16<D, false> E{PBUF, nullptr, nullptr}; run_gemm(lds, PBF, (const bf16_t*)(wl + O_PP), D, PLE, E); }
                if (l == 0 && CONV_LATE > 0) { __syncthreads(); convert_weights(in, ws, (LAS float*)(lds + wave * 16384), gw, ngw, lane, NL * CONV_PER_LAYER - CONV_LATE, NL * CONV_PER_LAYER); }
            }
            GSYNC();
        }
        { EpiResid E{XA, XA, 1.0f, rss2, part}; run_gemm(lds, YB, (const bf16_t*)(wl + O_OUT), D, D, E); }
        GSYNC();
        { EpiSwiglu E{R1, rss2}; run_gemm(lds, XA, (const bf16_t*)(wl + O_GU2), 2 * FF, D, E); }
        GSYNC();
        { EpiResid E{XA, XA, 0.5f, rss3, part}; run_gemm(lds, R1, (const bf16_t*)(wl + O_D2), D, FF, E, REV_DOWN); }
        GSYNC();
        { EpiPle E{XA, XB, PBUF, rss3, rss4, part}; run_gemm(lds, XA, (const bf16_t*)(wl + O_PG), D, D, E); }
        GSYNC();
    }
    final_norm_rows(XB, in[29], out, gw, ngw, lane);
}

extern "C" void kernel_launch(void* const* d_in, const int* in_sizes, int n_in, void* d_out, int out_size, void* d_ws, size_t ws_size, hipStream_t stream) {
    static int grid = 0;
    if (grid == 0) {
        if (n_in != 30 || out_size != T * D || ws_size < WS_END) { fprintf(stderr, "kernel_launch: unexpected shapes n_in %d out %d ws %zu (need %zu)\n", n_in, out_size, ws_size, (size_t)WS_END); grid = -1; return; }
        int dev = 0, cus = 0, per_cu = 0;
        (void)hipGetDevice(&dev);
        (void)hipDeviceGetAttribute(&cus, hipDeviceAttributeMultiprocessorCount, dev);
        (void)hipFuncSetAttribute((const void*)hymba_fwd, hipFuncAttributeMaxDynamicSharedMemorySize, LDS_BYTES);
        (void)hipOccupancyMaxActiveBlocksPerMultiprocessor(&per_cu, (const void*)hymba_fwd, NTHR, LDS_BYTES);
        if (per_cu < 1) per_cu = 1;
        (void)hipGetLastError();
        grid = cus * per_cu;
        fprintf(stderr, "kernel_launch: grid %d (cus %d x %d)\n", grid, cus, per_cu);
    }
    if (grid < 0) return;
    Args a{};
    for (int i = 0; i < 30; ++i) a.in[i] = (const float*)d_in[i];
    a.out = (float*)d_out; a.ws = (unsigned char*)d_ws;
    void* kargs[] = {&a};
    hipError_t e = hipLaunchCooperativeKernel((void*)hymba_fwd, dim3(grid), dim3(NTHR), kargs, LDS_BYTES, stream);
    if (e != hipSuccess) fprintf(stderr, "kernel_launch: cooperative launch failed: %s (grid %d)\n", hipGetErrorString(e), grid);
}
```

```cpp
#include <hip/hip_runtime.h>
#include <hip/hip_cooperative_groups.h>
#include <cstdio>
#include <cstdint>
namespace cg = cooperative_groups;
namespace pg8 {
#define PG8_LAS __attribute__((address_space(3)))
typedef unsigned short bf16_t;
typedef short bf16x8 __attribute__((ext_vector_type(8)));
typedef float f32x4 __attribute__((ext_vector_type(4)));
typedef unsigned u32x4 __attribute__((ext_vector_type(4)));
constexpr int BM = 256, BK = 64, HALF = 128, HTB = HALF * BK * 2  , STAGE_BYTES = 8 * HTB, NXCD = 8, WGM = 8;

__host__ __device__ __forceinline__ int lds_byte(int r, int c) { const int st = (r >> 4) * 2 + (c >> 5), rr = r & 15, cc = c & 31, ob = rr * 64 + cc * 2; return st * 1024 + (ob ^ (((ob >> 9) & 1) << 5)); }
__host__ __device__ __forceinline__ void stage_rc(int b, int& R, int& C) { const int st = b / 1024, sb = b % 1024, swz = sb ^ (((sb >> 9) & 1) << 5); R = (st >> 1) * 16 + swz / 64; C = (st & 1) * 32 + (swz % 64) / 2; }
__host__ __device__ __forceinline__ int perm32(int rho) { const int n = rho >> 4, i = rho & 15; return 8 * (i >> 2) + 4 * n + (i & 3); }

struct Unit { int pm, pn; };
struct Gemm { const bf16_t* A; const bf16_t* Bt; int M, N, K; };

struct StaticOrder {
    int nM, nN, nwg, G, c, rev;
    __host__ __device__ void init(int M, int N, int G_, int c_, int rev_ = 0) { nM = M / BM; nN = N / BM; nwg = nM * nN; G = G_; c = c_; rev = rev_; }
    __host__ __device__ bool next(int i, Unit& u) const {
        const long L = (long)i * G + c; if (L >= nwg) return false;
        int wgid = (int)L; { const int q = nwg / NXCD, r = nwg % NXCD, xcd = wgid % NXCD, off = wgid / NXCD; wgid = (xcd < r ? xcd * (q + 1) : r * (q + 1) + (xcd - r) * q) + off; }
        const int nig = WGM * nN, gid = wgid / nig, fm = gid * WGM, gsz = (nM - fm) < WGM ? (nM - fm) : WGM;
        u.pm = fm + ((wgid % nig) % gsz); u.pn = (wgid % nig) / gsz; if (rev) u.pm = nM - 1 - u.pm; return true;
    }
    __device__ __forceinline__ void a_ready(const Unit&) const {}
    __device__ __forceinline__ void done(const Unit&) const {}
};

__device__ __forceinline__ unsigned cvt_pk_bf16(float lo, float hi) { unsigned r; asm volatile("v_cvt_pk_bf16_f32 %0, %1, %2" : "=v"(r) : "v"(lo), "v"(hi)); return r; }
template <class Epi, class Sched, bool ALIGN_EPI = false, bool SP2 = false>
__device__ __forceinline__ void gemm_phase(PG8_LAS unsigned char* lds, const Gemm g, const Sched& S, const Epi& E) {
    int tid_ = threadIdx.x; asm volatile("" : "+v"(tid_));
    const int tid = tid_, wid = __builtin_amdgcn_readfirstlane(tid >> 6), lane = tid & 63, wr = wid >> 2, wc = wid & 3, fr = lane & 15, fq = lane >> 4;
    const int K = g.K, nt = K / BK;
    unsigned voffA[2], voffB[2];
#pragma unroll
    for (int i = 0; i < 2; ++i) { int R, C; stage_rc(tid * 16 + i * 8192, R, C); const int Rb = Epi::PERM ? ((R & ~31) + perm32(R & 31)) : R;
        voffA[i] = (unsigned)(R * K + C) * 2u; voffB[i] = (unsigned)(Rb * K + C) * 2u; }
    const size_t kstep = (size_t)(BK * 2);
    const size_t hstep = (size_t)HALF * K * 2;
    const size_t tstep = 2 * hstep;
    const unsigned ldsw = (unsigned)wid * 1024u;
    const int aoff = lds_byte(wr * 64 + fr, fq * 8), boff = lds_byte(wc * 32 + fr, fq * 8);
#define PG8_SA(b, h) (((b) * 2 + (h)) * HTB)
#define PG8_SB(b, h) ((4 + (b) * 2 + (h)) * HTB)
#define PG8_STAGE(bufoff, gbase, voff) do { _Pragma("unroll") for (int _i = 0; _i < 2; ++_i) \
        __builtin_amdgcn_global_load_lds((const unsigned*)((const char*)(gbase) + (voff)[_i]), (PG8_LAS unsigned*)(lds + (bufoff) + ldsw + _i * 8192), 16, 0, 0); } while (0)
#define PG8_LDA(dst, b, h) do { _Pragma("unroll") for (int m = 0; m < 4; ++m) _Pragma("unroll") for (int k = 0; k < 2; ++k) dst[m][k] = *(const PG8_LAS bf16x8*)(lds + PG8_SA(b, h) + aoff + m * 2048 + k * 1024); } while (0)
#define PG8_LDB(dst, b, h) do { _Pragma("unroll") for (int n = 0; n < 2; ++n) _Pragma("unroll") for (int k = 0; k < 2; ++k) dst[n][k] = *(const PG8_LAS bf16x8*)(lds + PG8_SB(b, h) + boff + n * 2048 + k * 1024); } while (0)
#define PG8_MMA(ai, bj, At, Bt) do { __builtin_amdgcn_s_setprio(1); _Pragma("unroll") for (int m = 0; m < 4; ++m) _Pragma("unroll") for (int n = 0; n < 2; ++n) _Pragma("unroll") for (int k = 0; k < 2; ++k) \
        acc[ai][bj][m][n] = __builtin_amdgcn_mfma_f32_16x16x32_bf16(Bt[n][k], At[m][k], acc[ai][bj][m][n], 0, 0, 0); __builtin_amdgcn_s_setprio(0); } while (0)
#define PG8_WAIT_V(n) asm volatile("s_waitcnt vmcnt(" #n ")" ::: "memory")
#define PG8_WAIT_L(n) asm volatile("s_waitcnt lgkmcnt(" #n ")" ::: "memory")
#define PG8_BAR __builtin_amdgcn_s_barrier()
#define PG8_SCHED __builtin_amdgcn_sched_barrier(0)
    Unit cur, nxt; int ui = 0;
    if (!S.next(0, cur)) return;
    f32x4 acc[2][2][4][2];
#pragma unroll
    for (int a = 0; a < 2; ++a)
#pragma unroll
        for (int b = 0; b < 2; ++b)
#pragma unroll
            for (int m = 0; m < 4; ++m)
#pragma unroll
                for (int n = 0; n < 2; ++n) acc[a][b][m][n] = (f32x4){0.f, 0.f, 0.f, 0.f};
    bf16x8 At[4][2], B0[2][2], B1[2][2];
    const char* cA = (const char*)g.A + (size_t)cur.pm * tstep; const char* cB = (const char*)g.Bt + (size_t)cur.pn * tstep;
    S.a_ready(cur);
    if constexpr (SP2) {
        PG8_STAGE(PG8_SB(0, 0), cB, voffB); PG8_STAGE(PG8_SB(0, 1), cB + hstep, voffB); PG8_STAGE(PG8_SA(0, 0), cA, voffA); PG8_STAGE(PG8_SA(0, 1), cA + hstep, voffA);
        if (wr == 1) PG8_BAR;
        PG8_WAIT_V(2); PG8_BAR;
        PG8_STAGE(PG8_SB(1, 0), cB + kstep, voffB); PG8_STAGE(PG8_SA(1, 0), cA + kstep, voffA); PG8_STAGE(PG8_SB(1, 1), cB + hstep + kstep, voffB);
        PG8_WAIT_V(6); PG8_BAR;
    } else {
        PG8_STAGE(PG8_SB(0, 0), cB, voffB); PG8_STAGE(PG8_SA(0, 0), cA, voffA); PG8_STAGE(PG8_SB(0, 1), cB + hstep, voffB); PG8_STAGE(PG8_SA(0, 1), cA + hstep, voffA);
        if (wr == 1) PG8_BAR;
        PG8_WAIT_V(4); PG8_BAR;
        PG8_STAGE(PG8_SB(1, 0), cB + kstep, voffB); PG8_STAGE(PG8_SA(1, 0), cA + kstep, voffA); PG8_STAGE(PG8_SB(1, 1), cB + hstep + kstep, voffB);
        PG8_WAIT_V(6); PG8_BAR;
    }
    for (;;) {
        const bool has_next = S.next(ui + 1, nxt);
        const char* nA = has_next ? (const char*)g.A + (size_t)nxt.pm * tstep : cA; const char* nB = has_next ? (const char*)g.Bt + (size_t)nxt.pn * tstep : cB;
        for (int t = 0; t < nt; t += 2) {
            const bool last = (t == nt - 2);
            const char* a1 = cA + (size_t)(t + 1) * kstep;
            const char* a2 = last ? nA : cA + (size_t)(t + 2) * kstep; const char* b2 = last ? nB : cB + (size_t)(t + 2) * kstep;
            const char* a3 = a2 + kstep; const char* b3 = b2 + kstep;
            if (last && has_next) S.a_ready(nxt);
            if constexpr (SP2) {
            PG8_LDB(B0, 0, 0); PG8_LDB(B1, 0, 1); PG8_SCHED; PG8_LDA(At, 0, 0); PG8_STAGE(PG8_SA(1, 1), a1 + hstep, voffA);
            PG8_WAIT_V(8); PG8_WAIT_L(0); PG8_BAR; PG8_MMA(0, 0, At, B0); PG8_MMA(0, 1, At, B1); PG8_BAR; PG8_SCHED;
            PG8_LDA(At, 0, 1); PG8_STAGE(PG8_SB(0, 0), b2, voffB); PG8_STAGE(PG8_SB(0, 1), b2 + hstep, voffB); PG8_STAGE(PG8_SA(0, 0), a2, voffA);
            PG8_WAIT_V(8); PG8_WAIT_L(0); PG8_BAR; PG8_MMA(1, 0, At, B0); PG8_MMA(1, 1, At, B1); PG8_BAR; PG8_SCHED;
            PG8_LDB(B0, 1, 0); PG8_LDB(B1, 1, 1); PG8_SCHED; PG8_LDA(At, 1, 0); PG8_STAGE(PG8_SA(0, 1), a2 + hstep, voffA);
            PG8_WAIT_V(8); PG8_WAIT_L(0); PG8_BAR; PG8_MMA(0, 0, At, B0); PG8_MMA(0, 1, At, B1); PG8_BAR; PG8_SCHED;
            PG8_LDA(At, 1, 1); PG8_STAGE(PG8_SB(1, 0), b3, voffB); PG8_STAGE(PG8_SB(1, 1), b3 + hstep, voffB); PG8_STAGE(PG8_SA(1, 0), a3, voffA);
            PG8_WAIT_V(8); PG8_WAIT_L(0); PG8_BAR; PG8_MMA(1, 0, At, B0); PG8_MMA(1, 1, At, B1); PG8_BAR; PG8_SCHED;
            } else {
            PG8_LDB(B0, 0, 0); PG8_SCHED; PG8_LDA(At, 0, 0); PG8_STAGE(PG8_SA(1, 1), a1 + hstep, voffA);
            PG8_WAIT_L(8); PG8_BAR; PG8_WAIT_L(0); PG8_MMA(0, 0, At, B0); PG8_BAR; PG8_SCHED;
            PG8_LDB(B1, 0, 1); PG8_STAGE(PG8_SB(0, 0), b2, voffB);
            PG8_BAR; PG8_WAIT_L(0); PG8_MMA(0, 1, At, B1); PG8_BAR;
            PG8_LDA(At, 0, 1); PG8_STAGE(PG8_SA(0, 0), a2, voffA);
            PG8_BAR; PG8_WAIT_L(0); PG8_MMA(1, 0, At, B0); PG8_BAR; PG8_SCHED;
            PG8_STAGE(PG8_SB(0, 1), b2 + hstep, voffB);
            PG8_WAIT_V(6); PG8_BAR; PG8_MMA(1, 1, At, B1); PG8_BAR;
            PG8_LDB(B0, 1, 0); PG8_SCHED; PG8_LDA(At, 1, 0); PG8_STAGE(PG8_SA(0, 1), a2 + hstep, voffA);
            PG8_WAIT_L(8); PG8_BAR; PG8_WAIT_L(0); PG8_MMA(0, 0, At, B0); PG8_BAR; PG8_SCHED;
            PG8_LDB(B1, 1, 1); PG8_STAGE(PG8_SB(1, 0), b3, voffB);
            PG8_BAR; PG8_WAIT_L(0); PG8_MMA(0, 1, At, B1); PG8_BAR;
            PG8_LDA(At, 1, 1); PG8_STAGE(PG8_SA(1, 0), a3, voffA);
            PG8_BAR; PG8_WAIT_L(0); PG8_MMA(1, 0, At, B0); PG8_BAR; PG8_SCHED;
            PG8_STAGE(PG8_SB(1, 1), b3 + hstep, voffB);
            PG8_WAIT_V(6); PG8_BAR; PG8_MMA(1, 1, At, B1); PG8_BAR;
            }
        }
        if constexpr (ALIGN_EPI) { if (wr == 0) PG8_BAR; }
        if constexpr (!Epi::AFTER_DRAIN) { E(acc, cur, wr, wc, fr, fq); S.done(cur); }
        if (!has_next) break;
#pragma unroll
        for (int a = 0; a < 2; ++a)
#pragma unroll
            for (int b = 0; b < 2; ++b)
#pragma unroll
                for (int m = 0; m < 4; ++m)
#pragma unroll
                    for (int n = 0; n < 2; ++n) acc[a][b][m][n] = (f32x4){0.f, 0.f, 0.f, 0.f};
        cur = nxt; cA = nA; cB = nB; ++ui;
        if constexpr (ALIGN_EPI) { if (wr == 1) PG8_BAR; }
    }
    PG8_WAIT_V(0);
    if constexpr (!ALIGN_EPI) { if (wr == 0) PG8_BAR; }
    PG8_BAR;
    if constexpr (Epi::AFTER_DRAIN) { E.fused(acc, cur, wr, wc, fr, fq, lds, wid, lane); S.done(cur); }
#undef PG8_SA
#undef PG8_SB
#undef PG8_STAGE
#undef PG8_LDA
#undef PG8_LDB
#undef PG8_MMA
#undef PG8_WAIT_V
#undef PG8_WAIT_L
#undef PG8_BAR
#undef PG8_SCHED
}
}

#define LAS __attribute__((address_space(3)))
typedef pg8::bf16_t bf16_t;
typedef pg8::f32x4 f32x4;
typedef pg8::bf16x8 bf16x8;
typedef unsigned u32x4v __attribute__((ext_vector_type(4)));
typedef unsigned u32x2v __attribute__((ext_vector_type(2)));
typedef short s16x4 __attribute__((ext_vector_type(4)));
constexpr int NBATCH = 16, SEQ = 2048, T = NBATCH * SEQ, D = 1024, FF = 2816, DIN = 2312, NIN = 2560, PLE = 256, NL = 2;
constexpr int U_LRUX = 0, U_LRUG = 256, U_AQ = 512, U_AK = 1024, U_AV = 1152, U_DQ = 1280, U_DZ = 2048;
constexpr float EPS = 1e-6f;
constexpr int NTHR = 512, NWAVES = 8;
constexpr int LDS_BYTES = 147456;
constexpr size_t MiB = 1u << 20;
constexpr size_t SZ_GU = 5632ull * 1024 * 2, SZ_DN = 1024ull * 2816 * 2, SZ_IN = 2560ull * 1024 * 2, SZ_SQ = 1024ull * 1024 * 2, SZ_PP = 1024ull * 256 * 2, SZ_LRU = 2ull * 4 * 64 * 64 * 2;
constexpr size_t O_GU1 = 0, O_D1 = O_GU1 + SZ_GU, O_GU2 = O_D1 + SZ_DN, O_D2 = O_GU2 + SZ_GU, O_IN = O_D2 + SZ_DN, O_OUT = O_IN + SZ_IN, O_PG = O_OUT + SZ_SQ, O_PP = O_PG + SZ_SQ, O_LRU = O_PP + SZ_PP, W_LAYER = O_LRU + SZ_LRU;
constexpr size_t WS_W = 1 * MiB, WS_XN = 89 * MiB, WS_R1 = 153 * MiB, WS_R2 = 329 * MiB, WS_END = 512 * MiB;
static_assert(WS_W + NL * W_LAYER <= WS_XN, "weights fit");
static_assert((size_t)T * FF * 2 <= WS_R2 - WS_R1, "act fits R1");
constexpr size_t R2_LH = 0, R2_PC = 16 * MiB, R2_AGG = 32 * MiB, R2_DQ = 34 * MiB, R2_DK = 50 * MiB, R2_DV = 66 * MiB, R2_UU = 82 * MiB, R2_GG = 98 * MiB, R2_BE = 98 * MiB + 512 * 1024, R2_DNBA = 99 * MiB,
                 R2_WW = 100 * MiB, R2_QG = 116 * MiB, R2_ATT = 132 * MiB, R2_KDT = 148 * MiB, R2_EGL = 164 * MiB, R2_USED = 165 * MiB;
constexpr size_t R2_CARRY = 181 * MiB;
static_assert(WS_R2 + R2_CARRY + (size_t)NBATCH * 64 * 256 * 4 <= WS_END, "carry fits");
constexpr size_t WS_UU = WS_R1 + 160 * MiB;
constexpr size_t R2_PBF = 165 * MiB, R2_PBUF = 34 * MiB, R2_XB = 100 * MiB;
static_assert(WS_UU + (size_t)T * 256 * 2 <= WS_R2 && R2_PBUF + (size_t)T * D * 2 <= 98 * MiB && R2_XB + (size_t)T * D * 2 <= 164 * MiB, "map");
constexpr size_t WS_RSS = 87 * MiB;
static_assert(WS_W + NL * W_LAYER <= WS_RSS && WS_RSS + 2 * 4 * (size_t)T * 4 <= WS_XN && R2_PBF + (size_t)T * PLE * 2 <= WS_END - WS_R2, "map");
static_assert(WS_R2 + R2_USED <= WS_END, "R2 fits");

__device__ __forceinline__ float bf2f(unsigned short b) { return __uint_as_float(((unsigned)b) << 16); }
__device__ __forceinline__ float bflo(unsigned w) { return __uint_as_float(w << 16); }
__device__ __forceinline__ float bfhi(unsigned w) { return __uint_as_float(w & 0xffff0000u); }
__device__ __forceinline__ unsigned pk2(float lo, float hi) { return pg8::cvt_pk_bf16(lo, hi); }
__device__ __forceinline__ unsigned short f2bf(float f) { return (unsigned short)(pg8::cvt_pk_bf16(f, 0.f) & 0xffffu); }
__device__ __forceinline__ float sigmoidf_(float x) { return __builtin_amdgcn_rcpf(1.0f + __expf(-x)); }
__device__ __forceinline__ float siluf_(float x) { return x * __builtin_amdgcn_rcpf(1.0f + __expf(-x)); }
__device__ __forceinline__ float softplusf_(float x) { const float e = __expf(-fabsf(x)); const float lg = (e < 0.03f) ? e * (1.0f - e * (0.5f - e * (0.33333334f - 0.25f * e))) : __logf(1.0f + e); return fmaxf(x, 0.f) + lg; }
__device__ __forceinline__ float gelu_tanh(float x) { const float u2 = 1.5957691216057308f * (x + 0.044715f * x * x * x); return x * __builtin_amdgcn_rcpf(1.0f + __expf(-u2)); }
#define DPP_ADD(v, ctrl) do { const int _t = __builtin_amdgcn_update_dpp(0, __builtin_bit_cast(int, (v)), (ctrl), 0xf, 0xf, true); (v) += __builtin_bit_cast(float, _t); } while (0)
__device__ __forceinline__ float wave_sum(float v) {
    DPP_ADD(v, 0xB1); DPP_ADD(v, 0x4E); DPP_ADD(v, 0x141); DPP_ADD(v, 0x140);
    const int vi = __builtin_bit_cast(int, v);
    const float r0 = __builtin_bit_cast(float, __builtin_amdgcn_readlane(vi, 0)), r1 = __builtin_bit_cast(float, __builtin_amdgcn_readlane(vi, 16)), r2 = __builtin_bit_cast(float, __builtin_amdgcn_readlane(vi, 32)), r3 = __builtin_bit_cast(float, __builtin_amdgcn_readlane(vi, 48));
    return (r0 + r1) + (r2 + r3);
}

__device__ __forceinline__ float rstd_of(const float* rss, int row) { const f32x4 p = *(const f32x4*)(rss + (size_t)row * 4); return 1.0f / sqrtf(((p[0] + p[1]) + (p[2] + p[3])) * (1.0f / D) + EPS); }
constexpr int EPI_LDS_OFF = 131072;
using pg8::Unit;
struct EpiSwiglu {
    static constexpr bool PERM = true, AFTER_DRAIN = false;
    bf16_t* O_; const float* rss_;
    __device__ __forceinline__ void operator()(const f32x4 (&acc)[2][2][4][2], const Unit& u, int wr, int wc, int fr, int fq) const {
        bf16_t* O = O_; const float* rss = rss_; asm volatile("" : "+s"(O), "+s"(rss));
        const int row0 = u.pm * 256 + wr * 64 + fr, col0 = u.pn * 128 + wc * 32 + 8 * fq;
        float rsv[2][4];
        { f32x4 pp[2][4];
#pragma unroll
          for (int ai = 0; ai < 2; ++ai)
#pragma unroll
            for (int m = 0; m < 4; ++m) pp[ai][m] = *(const f32x4*)(rss + (size_t)(row0 + ai * 128 + m * 16) * 4);
#pragma unroll
          for (int ai = 0; ai < 2; ++ai)
#pragma unroll
            for (int m = 0; m < 4; ++m) rsv[ai][m] = __builtin_amdgcn_rsqf(((pp[ai][m][0] + pp[ai][m][1]) + (pp[ai][m][2] + pp[ai][m][3])) * (1.0f / D) + EPS); }
#pragma unroll
        for (int ai = 0; ai < 2; ++ai)
#pragma unroll
            for (int m = 0; m < 4; ++m) {
                bf16_t* rowp = O + (size_t)(row0 + ai * 128 + m * 16) * FF + col0;
                const float rs = rsv[ai][m];
                float v[8];
#pragma unroll
                for (int n = 0; n < 2; ++n)
#pragma unroll
                    for (int j = 0; j < 4; ++j) { const float g = acc[ai][0][m][n][j] * rs, up = acc[ai][1][m][n][j] * rs; v[n * 4 + j] = g * __builtin_amdgcn_rcpf(1.0f + __expf(-g)) * up; }
                u32x4v w; w.x = pk2(v[0], v[1]); w.y = pk2(v[2], v[3]); w.z = pk2(v[4], v[5]); w.w = pk2(v[6], v[7]);
                *(u32x4v*)rowp = w;
            }
    }
};
struct EpiResid {
    static constexpr bool PERM = false, AFTER_DRAIN = false;
    const bf16_t* in_; bf16_t* out_; float scale_; float* rss_; LAS float* part;
    __device__ __forceinline__ void operator()(const f32x4 (&acc)[2][2][4][2], const Unit& u, int wr, int wc, int fr, int fq) const {
        const bf16_t* in = in_; bf16_t* out = out_; float scale = scale_; float* rss = rss_;
        asm volatile("" : "+s"(in), "+s"(out), "+s"(scale), "+s"(rss));
        const int row0 = u.pm * 256 + wr * 64 + fr, col0 = u.pn * 256 + wc * 32 + 4 * fq;
#pragma unroll
        for (int hb = 0; hb < 2; ++hb) {
            u32x2v rin[4][4];
#pragma unroll
            for (int gg = 0; gg < 4; ++gg) { const int g = hb * 4 + gg; const size_t offn = (size_t)(row0 + (g >> 2) * 128 + (g & 3) * 16) * D + col0;
#pragma unroll
                for (int k = 0; k < 4; ++k) rin[gg][k] = *(const u32x2v*)(in + offn + (k >> 1) * 128 + (k & 1) * 16); }
#pragma unroll
            for (int gg = 0; gg < 4; ++gg) {
                const int g = hb * 4 + gg, ai = g >> 2, m = g & 3, row = row0 + ai * 128 + m * 16;
                const size_t off = (size_t)row * D + col0;
                float ss = 0.f;
#pragma unroll
                for (int k = 0; k < 4; ++k) { const int bj = k >> 1, n = k & 1; const size_t o = off + bj * 128 + n * 16; const f32x4 a = acc[ai][bj][m][n] * scale; const u32x2v w0 = rin[gg][k];
                    f32x4 r; r[0] = bflo(w0.x) + a[0]; r[1] = bfhi(w0.x) + a[1]; r[2] = bflo(w0.y) + a[2]; r[3] = bfhi(w0.y) + a[3];
                    u32x2v w; w.x = pk2(r[0], r[1]); w.y = pk2(r[2], r[3]); *(u32x2v*)(out + o) = w; ss += (r[0] * r[0] + r[1] * r[1]) + (r[2] * r[2] + r[3] * r[3]); }
                ss += __shfl_xor(ss, 16); ss += __shfl_xor(ss, 32);
                if (fq == 0) part[(ai * 128 + wr * 64 + m * 16 + fr) * 4 + wc] = ss;
            }
        }
        asm volatile("s_waitcnt lgkmcnt(0)" ::: "memory"); __builtin_amdgcn_s_barrier(); asm volatile("" ::: "memory");
        { int t = threadIdx.x; asm volatile("" : "+v"(t)); if (t < 256) { const f32x4 p = *(const LAS f32x4*)(part + t * 4); rss[(size_t)(u.pm * 256 + t) * 4 + u.pn] = (p[0] + p[1]) + (p[2] + p[3]); } }
    }
};
template <int LD, bool SIDE> struct EpiBf16 {
    static constexpr bool PERM = true, AFTER_DRAIN = false;
    bf16_t* O_; float* side_; const float* rss_;
    __device__ __forceinline__ void operator()(const f32x4 (&acc)[2][2][4][2], const Unit& u, int wr, int wc, int fr, int fq) const {
        bf16_t* O = O_; float* side = side_; const float* rss = rss_; asm volatile("" : "+s"(O), "+s"(side), "+s"(rss));
        const int row0 = u.pm * 256 + wr * 64 + fr, col0 = u.pn * 256 + wc * 32 + 8 * fq;
        float rsv[2][4];
        if (SIDE) { f32x4 pp[2][4];
#pragma unroll
          for (int ai = 0; ai < 2; ++ai)
#pragma unroll
            for (int m = 0; m < 4; ++m) pp[ai][m] = *(const f32x4*)(rss + (size_t)(row0 + ai * 128 + m * 16) * 4);
#pragma unroll
          for (int ai = 0; ai < 2; ++ai)
#pragma unroll
            for (int m = 0; m < 4; ++m) rsv[ai][m] = __builtin_amdgcn_rsqf(((pp[ai][m][0] + pp[ai][m][1]) + (pp[ai][m][2] + pp[ai][m][3])) * (1.0f / D) + EPS); }
#pragma unroll
        for (int ai = 0; ai < 2; ++ai)
#pragma unroll
            for (int m = 0; m < 4; ++m) {
                const int row = row0 + ai * 128 + m * 16;
                bf16_t* rowp = O + (size_t)row * LD + col0;
                const float rs = SIDE ? rsv[ai][m] : 1.0f;
#pragma unroll
                for (int bj = 0; bj < 2; ++bj) {
                    const f32x4 v0 = acc[ai][bj][m][0] * rs, v1 = acc[ai][bj][m][1] * rs;
                    u32x4v w; w.x = pk2(v0[0], v0[1]); w.y = pk2(v0[2], v0[3]); w.z = pk2(v1[0], v1[1]); w.w = pk2(v1[2], v1[3]);
                    *(u32x4v*)(rowp + bj * 128) = w;
                    if (SIDE) { if (bj == 0 && u.pn == 9 && wc == 0 && fq == 0) { *(f32x4*)(side + (size_t)row * 8) = v0; *(f32x4*)(side + (size_t)row * 8 + 4) = v1; } }
                }
            }
    }
};
struct EpiPle {
    static constexpr bool PERM = false, AFTER_DRAIN = false;
    const bf16_t* in_; bf16_t* out_; const bf16_t* P_; const float* rss_; float* rss_out_; LAS float* part;
    __device__ __forceinline__ void operator()(const f32x4 (&acc)[2][2][4][2], const Unit& u, int wr, int wc, int fr, int fq) const {
        const bf16_t* in = in_; bf16_t* out = out_; const bf16_t* P = P_; const float* rss = rss_; float* rss_out = rss_out_;
        asm volatile("" : "+s"(in), "+s"(out), "+s"(P), "+s"(rss), "+s"(rss_out));
        const int row0 = u.pm * 256 + wr * 64 + fr, col0 = u.pn * 256 + wc * 32 + 4 * fq;
        float rsv[8];
        { f32x4 pp[8];
#pragma unroll
          for (int g = 0; g < 8; ++g) pp[g] = *(const f32x4*)(rss + (size_t)(row0 + (g >> 2) * 128 + (g & 3) * 16) * 4);
#pragma unroll
          for (int g = 0; g < 8; ++g) rsv[g] = __builtin_amdgcn_rsqf(((pp[g][0] + pp[g][1]) + (pp[g][2] + pp[g][3])) * (1.0f / D) + EPS); }
#pragma unroll
        for (int hb = 0; hb < 4; ++hb) {
            u32x2v rin[2][4], pin[2][4];
#pragma unroll
            for (int gg = 0; gg < 2; ++gg) { const int g = hb * 2 + gg; const size_t offn = (size_t)(row0 + (g >> 2) * 128 + (g & 3) * 16) * D + col0;
#pragma unroll
                for (int k = 0; k < 4; ++k) { const size_t o = offn + (k >> 1) * 128 + (k & 1) * 16; rin[gg][k] = *(const u32x2v*)(in + o); pin[gg][k] = *(const u32x2v*)(P + o); } }
#pragma unroll
            for (int gg = 0; gg < 2; ++gg) {
                const int g = hb * 2 + gg, ai = g >> 2, m = g & 3, row = row0 + ai * 128 + m * 16;
                const size_t off = (size_t)row * D + col0;
                const float rs = rsv[g];
                float ss = 0.f;
#pragma unroll
                for (int k = 0; k < 4; ++k) { const int bj = k >> 1, n = k & 1; const size_t o = off + bj * 128 + n * 16;
                    const u32x2v rw = rin[gg][k], pw = pin[gg][k]; const f32x4 a = acc[ai][bj][m][n] * rs;
                    f32x4 res; res[0] = bflo(rw.x) + sigmoidf_(a[0]) * bflo(pw.x); res[1] = bfhi(rw.x) + sigmoidf_(a[1]) * bfhi(pw.x); res[2] = bflo(rw.y) + sigmoidf_(a[2]) * bflo(pw.y); res[3] = bfhi(rw.y) + sigmoidf_(a[3]) * bfhi(pw.y);
                    u32x2v w; w.x = pk2(res[0], res[1]); w.y = pk2(res[2], res[3]); *(u32x2v*)(out + o) = w; ss += (res[0] * res[0] + res[1] * res[1]) + (res[2] * res[2] + res[3] * res[3]); }
                ss += __shfl_xor(ss, 16); ss += __shfl_xor(ss, 32); if (fq == 0) part[(ai * 128 + wr * 64 + m * 16 + fr) * 4 + wc] = ss;
            }
        }
        asm volatile("s_waitcnt lgkmcnt(0)" ::: "memory"); __builtin_amdgcn_s_barrier(); asm volatile("" ::: "memory");
        { int t = threadIdx.x; asm volatile("" : "+v"(t)); if (t < 256) { const f32x4 p = *(const LAS f32x4*)(part + t * 4); rss_out[(size_t)(u.pm * 256 + t) * 4 + u.pn] = (p[0] + p[1]) + (p[2] + p[3]); } }
    }
};

struct ConvItem { const float* W; const float* gain; bf16_t* WT; int N, ldk, drow0, k0, n0; };
constexpr int CONV_PER_LAYER = 4 * 16 * 88 + 2 * 44 * 32 + 16 * 80 + 2 * 16 * 32 + 4 * 32 + 2 * 8;
__device__ __forceinline__ ConvItem conv_decode(const float* const* in, unsigned char* ws, int it) {
    constexpr int I_GU = 16 * 88, I_DN = 44 * 32, I_IN = 16 * 80, I_SQ = 16 * 32, I_PP = 4 * 32, I_LR = 8;
    static_assert(4 * I_GU + 2 * I_DN + I_IN + 2 * I_SQ + I_PP + 2 * I_LR == CONV_PER_LAYER, "items");
    const int l = it / CONV_PER_LAYER; int r = it % CONV_PER_LAYER;
    unsigned char* wl = ws + WS_W + (size_t)l * W_LAYER;
    ConvItem c;
    if (r < 4 * I_GU) {
        const int which = r / I_GU; r %= I_GU;
        const int kb = r / 88, nb = r % 88, n0 = nb * 32;
        c.W = in[which == 0 ? 3 : which == 1 ? 4 : which == 2 ? 23 : 24] + (size_t)l * D * FF; c.gain = in[which < 2 ? 2 : 22] + l * D; c.WT = (bf16_t*)(wl + (which < 2 ? O_GU1 : O_GU2));
        c.N = FF; c.ldk = D; c.drow0 = (n0 / 128) * 256 + (n0 % 128) + (which & 1) * 128; c.k0 = kb * 64; c.n0 = n0; return c; }
    r -= 4 * I_GU;
    if (r < 2 * I_DN) { const int which = r / I_DN; r %= I_DN; const int kb = r / 32, nb = r % 32;
        c.W = in[which == 0 ? 5 : 25] + (size_t)l * FF * D; c.gain = nullptr; c.WT = (bf16_t*)(wl + (which == 0 ? O_D1 : O_D2)); c.N = D; c.ldk = FF; c.drow0 = nb * 32; c.k0 = kb * 64; c.n0 = nb * 32; return c; }
    r -= 2 * I_DN;
    if (r < I_IN) { const int kb = r / 80, nb = r % 80;
        c.W = in[7] + (size_t)l * D * DIN; c.gain = in[6] + l * D; c.WT = (bf16_t*)(wl + O_IN); c.N = DIN; c.ldk = D; c.drow0 = nb * 32; c.k0 = kb * 64; c.n0 = nb * 32; return c; }
    r -= I_IN;
    if (r < 2 * I_SQ) { const int which = r / I_SQ; r %= I_SQ; const int kb = r / 32, nb = r % 32;
        c.W = in[which == 0 ? 21 : 27] + (size_t)l * D * D; c.gain = which == 0 ? nullptr : in[26] + l * D; c.WT = (bf16_t*)(wl + (which == 0 ? O_OUT : O_PG)); c.N = D; c.ldk = D; c.drow0 = nb * 32; c.k0 = kb * 64; c.n0 = nb * 32; return c; }
    r -= 2 * I_SQ;
    if (r < I_PP) { const int kb = r / 32, nb = r % 32;
        c.W = in[28] + (size_t)l * PLE * D; c.gain = nullptr; c.WT = (bf16_t*)(wl + O_PP); c.N = D; c.ldk = PLE; c.drow0 = nb * 32; c.k0 = kb * 64; c.n0 = nb * 32; return c; }
    r -= I_PP;
    {
        const int which = r / I_LR; r %= I_LR; const int hb = r / 2, nb = r % 2;
        c.W = in[which == 0 ? 10 : 12] + (size_t)l * 4 * 4096 + hb * 4096; c.gain = nullptr; c.WT = (bf16_t*)(wl + O_LRU) + which * 16384 + hb * 4096; c.N = 64; c.ldk = 64; c.drow0 = nb * 32; c.k0 = 0; c.n0 = nb * 32; return c; }
}
__device__ __forceinline__ void conv_load(const ConvItem& c, int lane, float (&v)[32], float (&g)[32]) {
    const int n = c.n0 + (lane & 31); const bool ok = n < c.N;
#pragma unroll
    for (int i = 0; i < 32; ++i) { const int kk = 2 * i + (lane >> 5); v[i] = ok ? c.W[(size_t)(c.k0 + kk) * c.N + n] : 0.f; g[i] = c.gain ? c.gain[c.k0 + kk] : 1.0f; }
}
__device__ __forceinline__ void conv_finish(const ConvItem& c, int lane, const float (&v)[32], const float (&g)[32], LAS float* scr) {
#pragma unroll
    for (int i = 0; i < 32; ++i) { const int kk = 2 * i + (lane >> 5); scr[kk * 33 + (lane & 31)] = v[i] * g[i]; }
    asm volatile("s_waitcnt lgkmcnt(0)" ::: "memory");
    const int cc = lane & 7;
#pragma unroll
    for (int j = 0; j < 4; ++j) { const int n = (lane >> 3) + 8 * j; const LAS float* s = scr + (8 * cc) * 33 + n;
        u32x4v o; o.x = pk2(s[0 * 33], s[1 * 33]); o.y = pk2(s[2 * 33], s[3 * 33]); o.z = pk2(s[4 * 33], s[5 * 33]); o.w = pk2(s[6 * 33], s[7 * 33]);
        *(u32x4v*)(c.WT + (size_t)(c.drow0 + n) * c.ldk + c.k0 + 8 * cc) = o; }
    asm volatile("s_waitcnt lgkmcnt(0)" ::: "memory");
}
__device__ __forceinline__ void convert_weights(const float* const* in, unsigned char* ws, LAS float* scr, int gw, int ngw, int lane, int it_lo, int it_hi) {
    asm volatile("" : "+v"(lane));
    int it = it_lo + gw;
    if (it >= it_hi) return;
    ConvItem cur = conv_decode(in, ws, it);
    float va[32], ga[32], vb[32], gb[32];
    conv_load(cur, lane, va, ga);
    for (;;) {
        const int nx = it + ngw; const bool more = nx < it_hi;
        ConvItem nxt = cur;
        if (more) { nxt = conv_decode(in, ws, nx); conv_load(nxt, lane, vb, gb); }
        conv_finish(cur, lane, va, ga, scr);
        if (!more) break;
#pragma unroll
        for (int i = 0; i < 32; ++i) { va[i] = vb[i]; ga[i] = gb[i]; }
        cur = nxt; it = nx;
    }
}

__device__ __forceinline__ void rows_bf16_sumsq(const float* h, bf16_t* xn, float* rss, int gw, int ngw, int lane) {
    asm volatile("" : "+v"(lane));
    for (int m0 = gw; m0 < T; m0 += 2 * ngw) {
        const int m1 = (m0 + ngw < T) ? m0 + ngw : m0;
        f32x4 va[4], vb[4];
#pragma unroll
        for (int j = 0; j < 4; ++j) { va[j] = __builtin_nontemporal_load((const f32x4*)(h + (size_t)m0 * D) + lane + 64 * j); vb[j] = __builtin_nontemporal_load((const f32x4*)(h + (size_t)m1 * D) + lane + 64 * j); }
#pragma unroll
        for (int rr = 0; rr < 2; ++rr) {
            const int m = rr == 0 ? m0 : m1;
            float s = 0.f;
#pragma unroll
            for (int j = 0; j < 4; ++j) { const f32x4 v = rr == 0 ? va[j] : vb[j]; s += (v[0] * v[0] + v[1] * v[1]) + (v[2] * v[2] + v[3] * v[3]); }
            s = wave_sum(s);
            if (rr == 0 || m1 != m0) {
                u32x2v* o8 = (u32x2v*)(xn + (size_t)m * D) + lane;
#pragma unroll
                for (int j = 0; j < 4; ++j) { const f32x4 v = rr == 0 ? va[j] : vb[j]; u32x2v w; w.x = pk2(v[0], v[1]); w.y = pk2(v[2], v[3]); o8[64 * j] = w; }
                if (lane == 0) *(f32x4*)(rss + (size_t)m * 4) = (f32x4){s, 0.f, 0.f, 0.f};
            }
        }
    }
}
__device__ __forceinline__ void norm_rows_bf16(const float* h, const float* g, bf16_t* xn, int gw, int ngw, int lane) {
    asm volatile("" : "+v"(lane));
    f32x4 gv[4];
#pragma unroll
    for (int j = 0; j < 4; ++j) gv[j] = ((const f32x4*)g)[lane + 64 * j];
    for (int m = gw; m < T; m += ngw) {
        const f32x4* xr = (const f32x4*)(h + (size_t)m * D) + lane;
        f32x4 v[4]; float s = 0.f;
#pragma unroll
        for (int j = 0; j < 4; ++j) { v[j] = xr[64 * j]; s += (v[j][0] * v[j][0] + v[j][1] * v[j][1]) + (v[j][2] * v[j][2] + v[j][3] * v[j][3]); }
        const float rstd = 1.0f / sqrtf(wave_sum(s) * (1.0f / D) + EPS);
        u32x2v* o8 = (u32x2v*)(xn + (size_t)m * D) + lane;
#pragma unroll
        for (int j = 0; j < 4; ++j) { u32x2v w; w.x = pk2(v[j][0] * rstd * gv[j][0], v[j][1] * rstd * gv[j][1]); w.y = pk2(v[j][2] * rstd * gv[j][2], v[j][3] * rstd * gv[j][3]); o8[64 * j] = w; }
    }
}
__device__ __forceinline__ void final_norm_rows(const bf16_t* h, const float* g, float* out, int gw, int ngw, int lane) {
    asm volatile("" : "+v"(lane));
    f32x4 gv[4];
#pragma unroll
    for (int j = 0; j < 4; ++j) gv[j] = ((const f32x4*)g)[lane + 64 * j];
    for (int m0 = gw; m0 < T; m0 += 2 * ngw) {
        const int m1 = (m0 + ngw < T) ? m0 + ngw : m0;
        u32x2v w0[4], w1[4];
#pragma unroll
        for (int j = 0; j < 4; ++j) { w0[j] = ((const u32x2v*)(h + (size_t)m0 * D) + lane)[64 * j]; w1[j] = ((const u32x2v*)(h + (size_t)m1 * D) + lane)[64 * j]; }
#pragma unroll
        for (int rr = 0; rr < 2; ++rr) {
            const int m = rr == 0 ? m0 : m1;
            f32x4 v[4]; float s = 0.f;
#pragma unroll
            for (int j = 0; j < 4; ++j) { const u32x2v w = rr == 0 ? w0[j] : w1[j]; v[j][0] = bflo(w.x); v[j][1] = bfhi(w.x); v[j][2] = bflo(w.y); v[j][3] = bfhi(w.y); s += (v[j][0] * v[j][0] + v[j][1] * v[j][1]) + (v[j][2] * v[j][2] + v[j][3] * v[j][3]); }
            const float rstd = 1.0f / sqrtf(wave_sum(s) * (1.0f / D) + EPS);
            f32x4* o = (f32x4*)(out + (size_t)m * D) + lane;
            if (rr == 0 || m1 != m0) {
#pragma unroll
                for (int j = 0; j < 4; ++j) __builtin_nontemporal_store(v[j] * rstd * gv[j], o + 64 * j);
            }
        }
    }
}
__device__ __forceinline__ void convert_p(const float* p, bf16_t* pbf, size_t gtid, size_t gthreads) {
    asm volatile("" : "+v"(gtid));
    const size_t n8 = (size_t)T * PLE / 8;
    for (size_t i = gtid; i < n8; i += gthreads) { const f32x4 a = ((const f32x4*)p)[2 * i], b = ((const f32x4*)p)[2 * i + 1];
        u32x4v w; w.x = pk2(a[0], a[1]); w.y = pk2(a[2], a[3]); w.z = pk2(b[0], b[1]); w.w = pk2(b[2], b[3]); ((u32x4v*)pbf)[i] = w; }
}

#define MFMA16(a, b, c) __builtin_amdgcn_mfma_f32_16x16x32_bf16((a), (b), (c), 0, 0, 0)

#define XB_TMO      128
#define XB_XCNT(j)  (256  + 64 * (j))
#define XB_XSUB(j)  (1280 + 64 * (j))
#define XB_XGEN(j)  (2304 + 64 * (j))
#define XB_TOP      3328
#define XB_TOPGEN   3392
#define XCD_BAR_WORDS 3456
#define XB_SPIN_CAP (1u << 18)

__device__ __forceinline__ unsigned xb_ld(unsigned* p)              { return __hip_atomic_load(p, __ATOMIC_RELAXED, __HIP_MEMORY_SCOPE_AGENT); }
__device__ __forceinline__ unsigned xb_add(unsigned* p, unsigned v) { return __hip_atomic_fetch_add(p, v, __ATOMIC_RELAXED, __HIP_MEMORY_SCOPE_AGENT); }
__device__ __forceinline__ unsigned xb_xcc_id() { return (unsigned)__builtin_amdgcn_s_getreg((3 << 11) | 20) & 0xFu; }
#define XB_SPIN(cond, bar) do { unsigned _sp = 0; while (cond) { __builtin_amdgcn_s_sleep(8); \
    if ((++_sp & 255u) == 0u) { if (xb_ld(&(bar)[XB_TMO])) break; if (_sp > XB_SPIN_CAP) { atomicAdd(&(bar)[XB_TMO], 1u); break; } } } } while (0)

struct XcdBarrier {
    unsigned* bar; unsigned x;
    volatile LAS unsigned* st;
};

__device__ __forceinline__ XcdBarrier xcd_barrier_post(unsigned* bar, volatile LAS unsigned* st) {
    XcdBarrier b; b.bar = bar; b.x = xb_xcc_id(); b.st = st;
    if (threadIdx.x == 0) (void)xb_add(&bar[XB_XCNT(b.x)], 1u);
    return b;
}
__device__ __forceinline__ void xcd_barrier_complete(unsigned* bar, unsigned x, unsigned& nloc, unsigned& nx) {
    const unsigned G = gridDim.x * gridDim.y * gridDim.z;
    unsigned sum, cnt, mine, sp = 0u;
    for (;;) {
        sum = 0u; cnt = 0u; mine = 0u;
#pragma unroll
        for (unsigned j = 0; j < 16; ++j) { const unsigned c = xb_ld(&bar[XB_XCNT(j)]); sum += c; cnt += (c > 0u) ? 1u : 0u; mine = (j == x) ? c : mine; }
        if (sum == G) break;
        __builtin_amdgcn_s_sleep(1);
        if ((++sp & 255u) == 0u) { if (xb_ld(&bar[XB_TMO])) break; if (sp > XB_SPIN_CAP) { atomicAdd(&bar[XB_TMO], 1u); break; } }
    }
    nloc = mine > 0u ? mine : 1u; nx = cnt > 0u ? cnt : 1u;
}

__device__ __forceinline__ void xcd_barrier(const XcdBarrier& b) {
    asm volatile("s_waitcnt vmcnt(0)" ::: "memory");
    __syncthreads();
    if (threadIdx.x == 0) {
        unsigned* bar = b.bar;
        __builtin_amdgcn_s_waitcnt(0);
        unsigned nloc = b.st[0], nx = b.st[1];
        if (nloc == 0u) { xcd_barrier_complete(bar, b.x, nloc, nx); b.st[0] = nloc; b.st[1] = nx; }
        const unsigned old = xb_add(&bar[XB_XSUB(b.x)], 1u);
        const unsigned gen = old / nloc;
        if (old + 1u == (gen + 1u) * nloc) {
            __builtin_amdgcn_fence(__ATOMIC_RELEASE, "agent");
            asm volatile("s_waitcnt vmcnt(0)" ::: "memory");
            const unsigned og = xb_add(&bar[XB_TOP], 1u);
            const unsigned tg = og / nx;
            if (og + 1u == (tg + 1u) * nx) xb_add(&bar[XB_TOPGEN], 1u);
            else XB_SPIN(xb_ld(&bar[XB_TOPGEN]) == tg, bar);
            __builtin_amdgcn_fence(__ATOMIC_ACQUIRE, "agent");
            xb_add(&bar[XB_XGEN(b.x)], 1u);
            asm volatile("s_waitcnt vmcnt(0)" ::: "memory");
        } else {
            XB_SPIN(xb_ld(&bar[XB_XGEN(b.x)]) == gen, bar);
            __builtin_amdgcn_fence(__ATOMIC_ACQUIRE, "agent");
            asm volatile("s_waitcnt vmcnt(0)" ::: "memory");
        }
    }
    __syncthreads();
}


__device__ __forceinline__ void mixer_pre_item(int item, const float* const* in, int l, unsigned char* ws, LAS unsigned char* lds, int tid, int lane, int wave) {
    asm volatile("" : "+v"(tid)); lane = tid & 63; wave = __builtin_amdgcn_readfirstlane(tid >> 6);
    const int b = item >> 6, c = item & 63, s0 = c * 32;
    const size_t g0 = (size_t)b * SEQ + s0;
    const bf16_t* U = (const bf16_t*)(ws + WS_R1);
    LAS bf16_t* STGL = (LAS bf16_t*)lds;
    LAS bf16_t* STGD = (LAS bf16_t*)(lds + 17920);
    LAS float* XRF = (LAS float*)(lds + 17920);
    LAS float* AF = (LAS float*)(lds + 50688);
    LAS bf16_t* XRB = (LAS bf16_t*)(lds + 83456);
    __syncthreads();
#pragma unroll
    for (int i = 0; i < 9; ++i) { const int id = tid + 512 * i;
        if (id < 35 * 128) { const int row = id >> 7, pc = id & 127, s = s0 - 3 + row;
            u32x4v v = (u32x4v){0u, 0u, 0u, 0u};
            if (s >= 0) v = *(const u32x4v*)(U + ((size_t)b * SEQ + s) * NIN + (pc < 32 ? pc * 8 : U_DQ + (pc - 32) * 8));
            if (pc < 32) *(LAS u32x4v*)(STGL + row * 256 + pc * 8) = v; else *(LAS u32x4v*)(STGD + row * 768 + (pc - 32) * 8) = v; } }
    __syncthreads();
    for (int task = wave; task < 24; task += 8) {
        const int g = task >> 1, t0 = (task & 1) * 16, kind = g >> 2, hh = g & 3, cc = g * 64 + lane;
        const float* cw = in[17] + (size_t)l * 4 * 768;
        const float w0 = cw[cc], w1 = cw[768 + cc], w2 = cw[1536 + cc], w3 = cw[2304 + cc];
        bf16_t* dst = (bf16_t*)(ws + WS_R2 + (kind == 0 ? R2_DQ : kind == 1 ? R2_DK : R2_DV)) + (g0 + t0) * 256 + hh * 64 + lane;
        float xm3 = bf2f(STGD[t0 * 768 + cc]), xm2 = bf2f(STGD[(t0 + 1) * 768 + cc]), xm1 = bf2f(STGD[(t0 + 2) * 768 + cc]);
        const float qs = (kind == 0) ? 0.125f : 1.0f;
#pragma unroll 8
        for (int t = 0; t < 16; ++t) { const float xc = bf2f(STGD[(t0 + t + 3) * 768 + cc]); float y = siluf_(w0 * xm3 + w1 * xm2 + w2 * xm1 + w3 * xc);
            if (kind < 2) { const float ss = wave_sum(y * y); y *= qs * __builtin_amdgcn_rsqf(ss + EPS); }
            dst[(size_t)t * 256] = f2bf(y);
            xm3 = xm2; xm2 = xm1; xm1 = xc; }
    }
    if (tid < 128) { const int tok = tid >> 2, hh = tid & 3; const float* sd = (const float*)(ws + WS_R2 + R2_DNBA) + (g0 + tok) * 8;
        const float beta = sigmoidf_(sd[hh]), g = -__expf(in[18][l * 4 + hh]) * softplusf_(sd[4 + hh] + in[19][l * 4 + hh]);
        ((float*)(ws + WS_R2 + R2_GG))[(g0 + tok) * 4 + hh] = g; ((float*)(ws + WS_R2 + R2_BE))[(g0 + tok) * 4 + hh] = beta; }
    __syncthreads();
    {
        const int ch = tid & 255, t0 = (tid >> 8) * 16;
        const float* cw = in[8] + (size_t)l * 4 * 256;
        const float w0 = cw[ch], w1 = cw[256 + ch], w2 = cw[512 + ch], w3 = cw[768 + ch], bb = in[9][l * 256 + ch];
        float xm3 = bf2f(STGL[t0 * 256 + ch]), xm2 = bf2f(STGL[(t0 + 1) * 256 + ch]), xm1 = bf2f(STGL[(t0 + 2) * 256 + ch]);
#pragma unroll 8
        for (int i = 0; i < 16; ++i) { const float xc = bf2f(STGL[(t0 + i + 3) * 256 + ch]); const float xr = w0 * xm3 + w1 * xm2 + w2 * xm1 + w3 * xc + bb;
            XRF[(t0 + i) * 256 + ch] = xr; XRB[(t0 + i) * 264 + ch] = f2bf(xr); xm3 = xm2; xm2 = xm1; xm1 = xc; }
    }
    __syncthreads();
    {
        const int hb = wave & 3, mf = wave >> 2, fr = lane & 15, q = lane >> 4;
        const bf16_t* WTa = (const bf16_t*)(ws + WS_W + (size_t)l * W_LAYER + O_LRU) + hb * 4096;
        const bf16_t* WTx = WTa + 16384;
        f32x4 aa[4], ax[4];
#pragma unroll
        for (int nf = 0; nf < 4; ++nf) { aa[nf] = (f32x4){0.f, 0.f, 0.f, 0.f}; ax[nf] = (f32x4){0.f, 0.f, 0.f, 0.f}; }
#pragma unroll
        for (int ks = 0; ks < 2; ++ks) {
            const bf16x8 A = *(const LAS bf16x8*)(XRB + (16 * mf + fr) * 264 + 64 * hb + 32 * ks + 8 * q);
#pragma unroll
            for (int nf = 0; nf < 4; ++nf) {
                const bf16x8 Ba = *(const bf16x8*)(WTa + (16 * nf + fr) * 64 + 32 * ks + 8 * q), Bx = *(const bf16x8*)(WTx + (16 * nf + fr) * 64 + 32 * ks + 8 * q);
                aa[nf] = MFMA16(A, Ba, aa[nf]); ax[nf] = MFMA16(A, Bx, ax[nf]); }
        }
#pragma unroll
        for (int nf = 0; nf < 4; ++nf) {
            const int ch = 64 * hb + 16 * nf + fr;
            const float ba = in[11][l * 256 + ch], bx = in[13][l * 256 + ch], sp = softplusf_(-in[14][l * 256 + ch]);
#pragma unroll
            for (int jj = 0; jj < 4; ++jj) { const int tok = 16 * mf + 4 * q + jj;
                const float r = sigmoidf_(aa[nf][jj] + ba), ig = sigmoidf_(ax[nf][jj] + bx), la = -8.0f * r * sp, a = __expf(la), x2 = 2.0f * la;
                const float om = (x2 > -0.25f) ? -x2 * (1.0f + x2 * (0.5f + x2 * (0.16666667f + x2 * (0.041666668f + x2 * (0.008333334f + x2 * 0.0013888889f))))) : 1.0f - a * a;
                const float mult = sqrtf(om);
                const float xr = XRF[tok * 256 + ch]; AF[tok * 256 + ch] = a; XRF[tok * 256 + ch] = mult * ig * xr; }
        }
    }
    __syncthreads();
    if (tid < 256) {
        float h = 0.f, P = 1.f;
        bf16_t* LH = (bf16_t*)(ws + WS_R2 + R2_LH) + g0 * 256 + tid; bf16_t* PC = (bf16_t*)(ws + WS_R2 + R2_PC) + g0 * 256 + tid;
#pragma unroll 8
        for (int t = 0; t < 32; ++t) { const float a = AF[t * 256 + tid], uu = XRF[t * 256 + tid]; h = a * h + uu; P *= a; LH[t * 256] = f2bf(h); PC[t * 256] = f2bf(P); }
        float2 ag; ag.x = P; ag.y = h; ((float2*)(ws + WS_R2 + R2_AGG))[(size_t)(b * 64 + c) * 256 + tid] = ag;
    }
}

__device__ __forceinline__ void dn_prep_item(int item, unsigned char* ws, LAS unsigned char* lds, int tid, int lane, int wave) {
    asm volatile("" : "+v"(tid)); lane = tid & 63; wave = __builtin_amdgcn_readfirstlane(tid >> 6);
    const int b = item >> 5, c = item & 31;
    const size_t tok0 = (size_t)b * SEQ + c * 64;
    LAS float* LM = (LAS float*)lds;
    LAS float* GC = (LAS float*)(lds + 65536);
    LAS float* BES = (LAS float*)(lds + 65536 + 2048);
    const bf16_t* DQ = (const bf16_t*)(ws + WS_R2 + R2_DQ); const bf16_t* DK = (const bf16_t*)(ws + WS_R2 + R2_DK);
    const bf16_t* DV = (const bf16_t*)(ws + WS_R2 + R2_DV); bf16_t* UUo = (bf16_t*)(ws + WS_UU);
    bf16_t* WW = (bf16_t*)(ws + WS_R2 + R2_WW); bf16_t* QG = (bf16_t*)(ws + WS_R2 + R2_QG); bf16_t* ATT = (bf16_t*)(ws + WS_R2 + R2_ATT); bf16_t* KDT = (bf16_t*)(ws + WS_R2 + R2_KDT);
    const int hd = wave >> 1, half = wave & 1, fr = lane & 15, q = lane >> 4;
    __syncthreads();
    float gc = ((const float*)(ws + WS_R2 + R2_GG))[(tok0 + lane) * 4 + hd];
    const float be_l = ((const float*)(ws + WS_R2 + R2_BE))[(tok0 + lane) * 4 + hd];
    bf16x8 Bk[4][2], Aq[2][2];
#pragma unroll
    for (int cf = 0; cf < 4; ++cf)
#pragma unroll
        for (int ks = 0; ks < 2; ++ks) Bk[cf][ks] = *(const bf16x8*)(DK + (tok0 + 16 * cf + fr) * 256 + hd * 64 + 32 * ks + 8 * q);
    bf16x8 Ak[2][2], Kd[4];
#pragma unroll
    for (int r2 = 0; r2 < 2; ++r2)
#pragma unroll
        for (int ks = 0; ks < 2; ++ks) { Aq[r2][ks] = *(const bf16x8*)(DQ + (tok0 + 16 * (2 * half + r2) + fr) * 256 + hd * 64 + 32 * ks + 8 * q); Ak[r2][ks] = *(const bf16x8*)(DK + (tok0 + 16 * (2 * half + r2) + fr) * 256 + hd * 64 + 32 * ks + 8 * q); }
#pragma unroll
    for (int cf = 0; cf < 4; ++cf) Kd[cf] = *(const bf16x8*)(DK + (tok0 + 16 * cf + fr) * 256 + hd * 64 + 32 * half + 8 * q);
    {
#pragma unroll
        for (int o = 1; o < 64; o <<= 1) { const float t = __shfl_up(gc, o); if (lane >= o) gc += t; }
        const float glast = __shfl(gc, 63);
        GC[wave * 64 + lane] = gc; BES[wave * 64 + lane] = be_l;
        if (half == 0 && lane == 0) ((float*)(ws + WS_R2 + R2_EGL))[(size_t)(b * 32 + c) * 4 + hd] = __expf(glast);
        asm volatile("s_waitcnt lgkmcnt(0)" ::: "memory");
        float gjv[4], giv[2][4], biv[2][4];
#pragma unroll
        for (int cf = 0; cf < 4; ++cf) gjv[cf] = GC[wave * 64 + 16 * cf + fr];
#pragma unroll
        for (int r2 = 0; r2 < 2; ++r2)
#pragma unroll
            for (int jj = 0; jj < 4; ++jj) { const int i = 16 * (2 * half + r2) + 4 * q + jj; giv[r2][jj] = GC[wave * 64 + i]; biv[r2][jj] = BES[wave * 64 + i]; }
        const float sc_q0 = __expf(GC[wave * 64 + 16 * (2 * half) + fr]), sc_q1 = __expf(GC[wave * 64 + 16 * (2 * half + 1) + fr]);
#pragma unroll
        for (int r2 = 0; r2 < 2; ++r2) { const int rf = 2 * half + r2;
#pragma unroll
            for (int cf = 0; cf < 4; ++cf) {
                f32x4 kk = (f32x4){0.f, 0.f, 0.f, 0.f}, qk = (f32x4){0.f, 0.f, 0.f, 0.f};
#pragma unroll
                for (int ks = 0; ks < 2; ++ks) { kk = MFMA16(Ak[r2][ks], Bk[cf][ks], kk); qk = MFMA16(Aq[r2][ks], Bk[cf][ks], qk); }
                const int j = 16 * cf + fr; const float gj = gjv[cf];
#pragma unroll
                for (int jj = 0; jj < 4; ++jj) { const int i = 16 * rf + 4 * q + jj; const float gi = giv[r2][jj], bi = biv[r2][jj];
                    const float dec = (j <= i) ? __expf(gi - gj) : 0.f;
                    LM[(hd * 64 + i) * 64 + j] = (j < i) ? bi * kk[jj] * dec : 0.f;
                    ATT[(tok0 + i) * 256 + hd * 64 + j] = f2bf(qk[jj] * dec); }
            }
        }
#pragma unroll
        for (int r2 = 0; r2 < 2; ++r2) { const int iq = 16 * (2 * half + r2) + fr; const float sc = r2 == 0 ? sc_q0 : sc_q1;
#pragma unroll
            for (int ks = 0; ks < 2; ++ks) { const u32x4v w = __builtin_bit_cast(u32x4v, Aq[r2][ks]);
                u32x4v r; r.x = pk2(bflo(w.x) * sc, bfhi(w.x) * sc); r.y = pk2(bflo(w.y) * sc, bfhi(w.y) * sc); r.z = pk2(bflo(w.z) * sc, bfhi(w.z) * sc); r.w = pk2(bflo(w.w) * sc, bfhi(w.w) * sc);
                *(u32x4v*)(QG + (tok0 + iq) * 256 + hd * 64 + 32 * ks + 8 * q) = r; } }
#pragma unroll
        for (int cf = 0; cf < 4; ++cf) { const int cj = 16 * cf + fr; const float sc = __expf(glast - gjv[cf]);
            const u32x4v w = __builtin_bit_cast(u32x4v, Kd[cf]);
            bf16_t* dp = KDT + (tok0 + 32 * half + 8 * q) * 256 + hd * 64 + cj;
            dp[0 * 256] = f2bf(bflo(w.x) * sc); dp[1 * 256] = f2bf(bfhi(w.x) * sc); dp[2 * 256] = f2bf(bflo(w.y) * sc); dp[3 * 256] = f2bf(bfhi(w.y) * sc);
            dp[4 * 256] = f2bf(bflo(w.z) * sc); dp[5 * 256] = f2bf(bfhi(w.z) * sc); dp[6 * 256] = f2bf(bflo(w.w) * sc); dp[7 * 256] = f2bf(bfhi(w.w) * sc); }
    }
    unsigned short xr[64];
    { const bf16_t* src = (half == 0 ? DV : DK) + tok0 * 256 + hd * 64 + lane;
#pragma unroll
      for (int i = 0; i < 64; ++i) xr[i] = src[(size_t)i * 256]; }
    __syncthreads();
    {
        const int col = lane;
        float x[64];
#ifdef PROBE_PHB
        for (int rep_ = 0; rep_ < PROBE_PHB; ++rep_) { asm volatile("" ::: "memory");
#endif
        const LAS float* bes = BES + (hd * 2) * 64; const LAS float* gcs = GC + (hd * 2) * 64;
        if (half == 0) {
#pragma unroll
            for (int i = 0; i < 64; ++i) x[i] = bf2f(xr[i]) * bes[i];
        } else {
#pragma unroll
            for (int i = 0; i < 64; ++i) x[i] = bf2f(xr[i]) * bes[i] * __expf(gcs[i]);
        }
        const LAS float* Lh = LM + hd * 4096;
#pragma unroll
        for (int i = 1; i < 64; ++i) {
            float acc = x[i];
#pragma unroll
            for (int j4 = 0; j4 < (i + 3) / 4; ++j4) { const f32x4 lv = *(const LAS f32x4*)(Lh + i * 64 + 4 * j4);
#pragma unroll
                for (int jj = 0; jj < 4; ++jj) if (4 * j4 + jj < i) acc -= lv[jj] * x[4 * j4 + jj]; }
            x[i] = acc;
        }
#ifdef PROBE_PHB
        asm volatile("" : "+v"(x[63])); }
#endif
        if (half == 0) {
#pragma unroll
            for (int i = 0; i < 64; ++i) UUo[(tok0 + i) * 256 + hd * 64 + col] = f2bf(x[i]);
        } else {
#pragma unroll
            for (int i = 0; i < 64; ++i) WW[(tok0 + i) * 256 + hd * 64 + col] = f2bf(x[i]);
        }
    }
}
__device__ __forceinline__ void dn_chain_item(int item, const float* const* in, int l, unsigned char* ws, bf16_t* ybuf, LAS unsigned char* lds, int tid, int lane, int wave) {
    asm volatile("" : "+v"(tid)); lane = tid & 63; wave = __builtin_amdgcn_readfirstlane(tid >> 6);
    const int b = item >> 2, hd = item & 3;
    LAS bf16_t* Wl = (LAS bf16_t*)lds; LAS bf16_t* QGl = Wl + 64 * 72; LAS bf16_t* ATl = QGl + 64 * 72; LAS bf16_t* KDl = ATl + 64 * 72;
    LAS bf16_t* UUl = (LAS bf16_t*)(lds + 36864); LAS float* OSl = (LAS float*)(lds + 53248);
    const bf16_t* WW = (const bf16_t*)(ws + WS_R2 + R2_WW); const bf16_t* QG = (const bf16_t*)(ws + WS_R2 + R2_QG); const bf16_t* ATT = (const bf16_t*)(ws + WS_R2 + R2_ATT); const bf16_t* KDT = (const bf16_t*)(ws + WS_R2 + R2_KDT);
    const bf16_t* UUg = (const bf16_t*)(ws + WS_UU); const float* EGL = (const float*)(ws + WS_R2 + R2_EGL);
    const bf16_t* U = (const bf16_t*)(ws + WS_R1); bf16_t* Y = ybuf;
    const int lr = tid >> 3, lp = tid & 7, fr = lane & 15, q = lane >> 4, ef = wave;
    const int orow = (tid & 255) >> 2, op = tid & 3;
    const size_t base = (size_t)b * SEQ * 256 + hd * 64;
    f32x4 Sacc[4];
#pragma unroll
    for (int df = 0; df < 4; ++df) Sacc[df] = (f32x4){0.f, 0.f, 0.f, 0.f};
    u32x4v rwA, rqA, raA, rkA, ruA, rz0A, rz1A, rwB, rqB, raB, rkB, ruB, rz0B, rz1B, pz0, pz1;
    rz0A = (u32x4v){0u, 0u, 0u, 0u}; rz1A = rz0A; rz0B = rz0A; rz1B = rz0A;
    pz0 = (u32x4v){0u, 0u, 0u, 0u}; pz1 = pz0;
#define DN_LOAD(cc, S) do { const size_t o = base + (size_t)((cc) * 64 + lr) * 256 + lp * 8; rw##S = *(const u32x4v*)(WW + o); rq##S = *(const u32x4v*)(QG + o); ra##S = *(const u32x4v*)(ATT + o); rk##S = *(const u32x4v*)(KDT + o); \
        ru##S = *(const u32x4v*)(UUg + o); \
        if (wave >= 4) { const bf16_t* zp = U + ((size_t)b * SEQ + (cc) * 64 + orow) * NIN + U_DZ + hd * 64 + op * 16; rz0##S = *(const u32x4v*)zp; rz1##S = *(const u32x4v*)(zp + 8); } } while (0)
#define DN_OUT(cc, zA, zB) do { const LAS float* os = OSl + ((cc) & 1) * 4096 + orow * 64 + op * 16; const f32x4 o0 = *(const LAS f32x4*)os, o1 = *(const LAS f32x4*)(os + 4), o2 = *(const LAS f32x4*)(os + 8), o3 = *(const LAS f32x4*)(os + 12); \
        float ss = (o0[0] * o0[0] + o0[1] * o0[1]) + (o0[2] * o0[2] + o0[3] * o0[3]) + (o1[0] * o1[0] + o1[1] * o1[1]) + (o1[2] * o1[2] + o1[3] * o1[3]) + (o2[0] * o2[0] + o2[1] * o2[1]) + (o2[2] * o2[2] + o2[3] * o2[3]) + (o3[0] * o3[0] + o3[1] * o3[1]) + (o3[2] * o3[2] + o3[3] * o3[3]); \
        ss += __shfl_xor(ss, 1); ss += __shfl_xor(ss, 2); \
        const float rs = 1.0f / sqrtf(ss * (1.0f / 64.0f) + EPS); \
        const f32x4 n0 = nwA * rs, n1 = nwB * rs, n2 = nwC * rs, n3 = nwD * rs; \
        u32x4v w0, w1; \
        w0.x = pk2(o0[0] * n0[0] * siluf_(bflo(zA.x)), o0[1] * n0[1] * siluf_(bfhi(zA.x))); w0.y = pk2(o0[2] * n0[2] * siluf_(bflo(zA.y)), o0[3] * n0[3] * siluf_(bfhi(zA.y))); \
        w0.z = pk2(o1[0] * n1[0] * siluf_(bflo(zA.z)), o1[1] * n1[1] * siluf_(bfhi(zA.z))); w0.w = pk2(o1[2] * n1[2] * siluf_(bflo(zA.w)), o1[3] * n1[3] * siluf_(bfhi(zA.w))); \
        w1.x = pk2(o2[0] * n2[0] * siluf_(bflo(zB.x)), o2[1] * n2[1] * siluf_(bfhi(zB.x))); w1.y = pk2(o2[2] * n2[2] * siluf_(bflo(zB.y)), o2[3] * n2[3] * siluf_(bfhi(zB.y))); \
        w1.z = pk2(o3[0] * n3[0] * siluf_(bflo(zB.z)), o3[1] * n3[1] * siluf_(bfhi(zB.z))); w1.w = pk2(o3[2] * n3[2] * siluf_(bflo(zB.w)), o3[3] * n3[3] * siluf_(bfhi(zB.w))); \
        bf16_t* yp = Y + ((size_t)b * SEQ + (cc) * 64 + orow) * D + 768 + hd * 64 + op * 16; *(u32x4v*)yp = w0; *(u32x4v*)(yp + 8) = w1; } while (0)
    const float* nwp = in[20] + l * 64 + op * 16; const f32x4 nwA = *(const f32x4*)nwp, nwB = *(const f32x4*)(nwp + 4), nwC = *(const f32x4*)(nwp + 8), nwD = *(const f32x4*)(nwp + 12);
#define DN_FRAG(P, row, s) ({ const LAS bf16_t* _p = (P) + (row) * 72 + 32 * (s) + 4 * q; const u32x2v _lo = *(const LAS u32x2v*)_p, _hi = *(const LAS u32x2v*)(_p + 16); u32x4v _w; _w.x = _lo.x; _w.y = _lo.y; _w.z = _hi.x; _w.w = _hi.y; __builtin_bit_cast(bf16x8, _w); })
#define DN_BODY(c, S) do { \
        *(LAS u32x4v*)(Wl + lr * 72 + lp * 8) = rw##S; *(LAS u32x4v*)(QGl + lr * 72 + lp * 8) = rq##S; *(LAS u32x4v*)(ATl + lr * 72 + lp * 8) = ra##S; *(LAS u32x4v*)(KDl + lr * 72 + lp * 8) = rk##S; \
        *(LAS u32x4v*)(UUl + lr * 72 + lp * 8) = ru##S; \
        const u32x4v cz0 = pz0, cz1 = pz1; \
        pz0 = rz0##S; pz1 = rz1##S; \
        const float egl = egl_n; egl_n = EGL[(size_t)(b * 32 + (c + 1 < 32 ? c + 1 : c)) * 4 + hd]; \
        __syncthreads(); \
        if (c + 2 < 32) DN_LOAD(c + 2, S); \
        if (wave < 4) { \
            LAS float* OSc = OSl + (c & 1) * 4096; \
            bf16x8 fr_[4][2]; float uu[4][4]; \
            bf16x8 Sb[2], Vb[2]; \
_Pragma("unroll") \
            for (int s = 0; s < 2; ++s) { u32x4v w; w.x = pk2(Sacc[2 * s][0], Sacc[2 * s][1]); w.y = pk2(Sacc[2 * s][2], Sacc[2 * s][3]); w.z = pk2(Sacc[2 * s + 1][0], Sacc[2 * s + 1][1]); w.w = pk2(Sacc[2 * s + 1][2], Sacc[2 * s + 1][3]); Sb[s] = __builtin_bit_cast(bf16x8, w); } \
            f32x4 vn[4], oo[4]; \
_Pragma("unroll") \
            for (int cf = 0; cf < 4; ++cf) \
_Pragma("unroll") \
                for (int s = 0; s < 2; ++s) fr_[cf][s] = DN_FRAG(Wl, 16 * cf + fr, s); \
_Pragma("unroll") \
            for (int cf = 0; cf < 4; ++cf) \
_Pragma("unroll") \
                for (int jj = 0; jj < 4; ++jj) uu[cf][jj] = bf2f(UUl[(16 * cf + 4 * q + jj) * 72 + 16 * ef + fr]); \
_Pragma("unroll") \
            for (int cf = 0; cf < 4; ++cf) { f32x4 a = (f32x4){0.f, 0.f, 0.f, 0.f}; a = MFMA16(fr_[cf][0], Sb[0], a); a = MFMA16(fr_[cf][1], Sb[1], a); vn[cf] = a; } \
_Pragma("unroll") \
            for (int cf = 0; cf < 4; ++cf) \
_Pragma("unroll") \
                for (int s = 0; s < 2; ++s) fr_[cf][s] = DN_FRAG(QGl, 16 * cf + fr, s); \
_Pragma("unroll") \
            for (int cf = 0; cf < 4; ++cf) { f32x4 a = (f32x4){0.f, 0.f, 0.f, 0.f}; a = MFMA16(fr_[cf][0], Sb[0], a); a = MFMA16(fr_[cf][1], Sb[1], a); oo[cf] = a; } \
_Pragma("unroll") \
            for (int cf = 0; cf < 4; ++cf) \
_Pragma("unroll") \
                for (int s = 0; s < 2; ++s) if (32 * s <= 16 * cf + 15) fr_[cf][s] = DN_FRAG(ATl, 16 * cf + fr, s); \
_Pragma("unroll") \
            for (int cf = 0; cf < 4; ++cf) \
_Pragma("unroll") \
                for (int jj = 0; jj < 4; ++jj) vn[cf][jj] = uu[cf][jj] - vn[cf][jj]; \
_Pragma("unroll") \
            for (int s = 0; s < 2; ++s) { u32x4v w; w.x = pk2(vn[2 * s][0], vn[2 * s][1]); w.y = pk2(vn[2 * s][2], vn[2 * s][3]); w.z = pk2(vn[2 * s + 1][0], vn[2 * s + 1][1]); w.w = pk2(vn[2 * s + 1][2], vn[2 * s + 1][3]); Vb[s] = __builtin_bit_cast(bf16x8, w); } \
_Pragma("unroll") \
            for (int cf = 0; cf < 4; ++cf) \
_Pragma("unroll") \
                for (int s = 0; s < 2; ++s) if (32 * s <= 16 * cf + 15) oo[cf] = MFMA16(fr_[cf][s], Vb[s], oo[cf]); \
_Pragma("unroll") \
            for (int cf = 0; cf < 4; ++cf) \
_Pragma("unroll") \
                for (int s = 0; s < 2; ++s) fr_[cf][s] = DN_FRAG(KDl, 16 * cf + fr, s); \
_Pragma("unroll") \
            for (int df = 0; df < 4; ++df) { f32x4 a = Sacc[df] * egl; a = MFMA16(fr_[df][0], Vb[0], a); a = MFMA16(fr_[df][1], Vb[1], a); Sacc[df] = a; } \
_Pragma("unroll") \
            for (int cf = 0; cf < 4; ++cf) \
_Pragma("unroll") \
                for (int jj = 0; jj < 4; ++jj) OSc[(16 * cf + 4 * q + jj) * 64 + 16 * ef + fr] = oo[cf][jj]; \
        } else if (c > 0) { DN_OUT(c - 1, cz0, cz1); } \
        __syncthreads(); \
    } while (0)
    DN_LOAD(0, A); DN_LOAD(1, B);
    float egl_n = EGL[(size_t)(b * 32) * 4 + hd];
    __syncthreads();
    for (int c2 = 0; c2 < 32; c2 += 2) { DN_BODY(c2, A); DN_BODY(c2 + 1, B); }
    if (wave >= 4) { DN_OUT(31, pz0, pz1); }
    __syncthreads();
#undef DN_LOAD
#undef DN_BODY
#undef DN_OUT
#undef DN_FRAG
}
__device__ __forceinline__ void lru_carry_item(int b, unsigned char* ws, int tid) {
    asm volatile("" : "+v"(tid));
    if (tid < 256) {
        const float2* AGG = (const float2*)(ws + WS_R2 + R2_AGG) + (size_t)b * 64 * 256 + tid;
        float* CARRY = (float*)(ws + WS_R2 + R2_CARRY) + (size_t)b * 64 * 256 + tid;
        float carry = 0.f;
#pragma unroll
        for (int h = 0; h < 2; ++h) {
            float2 ag[32];
#pragma unroll
            for (int k = 0; k < 32; ++k) ag[k] = AGG[(h * 32 + k) * 256];
#pragma unroll
            for (int k = 0; k < 32; ++k) { CARRY[(h * 32 + k) * 256] = carry; carry = ag[k].x * carry + ag[k].y; }
        }
    }
}
__device__ __forceinline__ void lru_fix_item(int item, unsigned char* ws, bf16_t* ybuf, int tid) {
    asm volatile("" : "+v"(tid));
    const int b = item >> 6, c = item & 63, cv = (tid & 31) * 8;
    const float* cp = (const float*)(ws + WS_R2 + R2_CARRY) + (size_t)(b * 64 + c) * 256 + cv;
    const f32x4 ca = *(const f32x4*)cp, cb = *(const f32x4*)(cp + 4);
    u32x4v lh[2], pc[2], gt_[2];
#pragma unroll
    for (int j = 0; j < 2; ++j) { const size_t gt = (size_t)b * SEQ + c * 32 + (tid >> 5) + 16 * j;
        lh[j] = *(const u32x4v*)((const bf16_t*)(ws + WS_R2 + R2_LH) + gt * 256 + cv); pc[j] = *(const u32x4v*)((const bf16_t*)(ws + WS_R2 + R2_PC) + gt * 256 + cv);
        gt_[j] = *(const u32x4v*)((const bf16_t*)(ws + WS_R1) + gt * NIN + U_LRUG + cv); }
#pragma unroll
    for (int j = 0; j < 2; ++j) { const size_t gt = (size_t)b * SEQ + c * 32 + (tid >> 5) + 16 * j;
        u32x4v o;
        o.x = pk2(gelu_tanh(bflo(gt_[j].x)) * (bflo(lh[j].x) + bflo(pc[j].x) * ca[0]), gelu_tanh(bfhi(gt_[j].x)) * (bfhi(lh[j].x) + bfhi(pc[j].x) * ca[1]));
        o.y = pk2(gelu_tanh(bflo(gt_[j].y)) * (bflo(lh[j].y) + bflo(pc[j].y) * ca[2]), gelu_tanh(bfhi(gt_[j].y)) * (bfhi(lh[j].y) + bfhi(pc[j].y) * ca[3]));
        o.z = pk2(gelu_tanh(bflo(gt_[j].z)) * (bflo(lh[j].z) + bflo(pc[j].z) * cb[0]), gelu_tanh(bfhi(gt_[j].z)) * (bfhi(lh[j].z) + bfhi(pc[j].z) * cb[1]));
        o.w = pk2(gelu_tanh(bflo(gt_[j].w)) * (bflo(lh[j].w) + bflo(pc[j].w) * cb[2]), gelu_tanh(bfhi(gt_[j].w)) * (bfhi(lh[j].w) + bfhi(pc[j].w) * cb[3]));
        *(u32x4v*)(ybuf + gt * D + cv) = o; }
}
constexpr int ATT_BT_OFF = 102400;
constexpr int ATT_CT_OFF = 73728;
__device__ __forceinline__ void attn_item(int item, const float* const* in, int l, unsigned char* ws, bf16_t* ybuf, LAS unsigned char* lds, int tid, int lane, int wave) {
    asm volatile("" : "+v"(tid)); lane = tid & 63; wave = __builtin_amdgcn_readfirstlane(tid >> 6);
    const int kh = item & 1, nb = (item >> 1) & 15, b = item >> 5;
    LAS bf16_t* KL = (LAS bf16_t*)lds;
    LAS bf16_t* VT = (LAS bf16_t*)(lds + 36864);
    const LAS float* BT = (const LAS float*)(lds + ATT_BT_OFF);
    LAS float* CT = (LAS float*)(lds + ATT_CT_OFF);
    const bf16_t* U = (const bf16_t*)(ws + WS_R1);
    bf16_t* Y = ybuf;
    const int hl = wave >> 1, hq = kh * 4 + hl, qhalf = wave & 1, fr = lane & 15, q = lane >> 4;
    bf16x8 Bq[4][2];
#pragma unroll
    for (int qg = 0; qg < 4; ++qg) { const bf16_t* qp = U + ((size_t)b * SEQ + nb * 128 + qhalf * 64 + qg * 16 + fr) * NIN + U_AQ + hq * 64 + 8 * q; Bq[qg][0] = *(const bf16x8*)qp; Bq[qg][1] = *(const bf16x8*)(qp + 32); }
    __syncthreads();
#pragma unroll
    for (int i = 0; i < 4; ++i) { const int key = tid & 255, part = (tid >> 8) + 2 * i, pos = (nb - 1) * 128 + key;
        u32x4v kv = (u32x4v){0u, 0u, 0u, 0u}, vv = (u32x4v){0u, 0u, 0u, 0u};
        if (pos >= 0) { const bf16_t* src = U + ((size_t)b * SEQ + pos) * NIN; kv = *(const u32x4v*)(src + 1024 + kh * 64 + part * 8); vv = *(const u32x4v*)(src + 1152 + kh * 64 + part * 8); }
        *(LAS u32x4v*)(KL + key * 72 + part * 8) = kv;
        LAS bf16_t* vd = VT + (part * 8) * 272 + key;
        vd[0] = (bf16_t)(vv.x & 0xffffu); vd[272] = (bf16_t)(vv.x >> 16); vd[2 * 272] = (bf16_t)(vv.y & 0xffffu); vd[3 * 272] = (bf16_t)(vv.y >> 16);
        vd[4 * 272] = (bf16_t)(vv.z & 0xffffu); vd[5 * 272] = (bf16_t)(vv.z >> 16); vd[6 * 272] = (bf16_t)(vv.w & 0xffffu); vd[7 * 272] = (bf16_t)(vv.w >> 16); }
    const float NEG_INF = -__builtin_inff();
    for (int e = tid; e < 4 * 4 * 384; e += NTHR) { const int h = e / 1536, r = e % 1536, sft = r / 384, x = (r % 384) - 128 + sft;
        CT[e] = (x >= 0 && x <= 127) ? BT[(kh * 4 + h) * 128 + (127 - x)] : NEG_INF; }
    __syncthreads();
    const float sink = in[15][l * 8 + hq];
#pragma unroll
    for (int qg = 0; qg < 4; ++qg) {
        const int i0 = qhalf * 64 + qg * 16, iq = i0 + fr, s_lo = 2 * qhalf + (qg >> 1);
        const size_t gt = (size_t)b * SEQ + nb * 128 + iq;
        const bf16x8 Bq0 = Bq[qg][0], Bq1 = Bq[qg][1];
        f32x4 acc[10];
#pragma unroll
        for (int r = 0; r < 10; ++r) { const LAS bf16_t* kp = KL + (16 * (2 * s_lo + r) + fr) * 72 + 8 * q;
            f32x4 a = (f32x4){0.f, 0.f, 0.f, 0.f}; a = MFMA16(*(const LAS bf16x8*)kp, Bq0, a); a = MFMA16(*(const LAS bf16x8*)(kp + 32), Bq1, a); acc[r] = a; }
        const int a1 = iq + 1, sft = (4 - (a1 & 3)) & 3, a4 = (a1 + sft) >> 2;
        const LAS float* ct = CT + (hl * 4 + sft) * 384 + 128 + 4 * (4 * (2 * s_lo) + q - a4);
        float mx = sink;
#pragma unroll
        for (int r = 0; r < 10; ++r) { const f32x4 tb = *(const LAS f32x4*)(ct + 16 * r); const bool dead = (nb == 0) && (2 * s_lo + r < 8);
#pragma unroll
            for (int jj = 0; jj < 4; ++jj) { float sc = acc[r][jj] * 0.125f + tb[jj]; sc = dead ? NEG_INF : sc; acc[r][jj] = sc; mx = fmaxf(mx, sc); } }
        mx = fmaxf(mx, __shfl_xor(mx, 16)); mx = fmaxf(mx, __shfl_xor(mx, 32));
        float sum = 0.f;
#pragma unroll
        for (int r = 0; r < 10; ++r)
#pragma unroll
            for (int jj = 0; jj < 4; ++jj) { const float ev = __expf(acc[r][jj] - mx); acc[r][jj] = ev; sum += ev; }
        sum += __shfl_xor(sum, 16); sum += __shfl_xor(sum, 32);
        const float inv = 1.0f / (sum + __expf(sink - mx));
        f32x4 o[4];
#pragma unroll
        for (int df = 0; df < 4; ++df) o[df] = (f32x4){0.f, 0.f, 0.f, 0.f};
#pragma unroll
        for (int s = 0; s < 5; ++s) {
            u32x4v pw; pw.x = pk2(acc[2 * s][0], acc[2 * s][1]); pw.y = pk2(acc[2 * s][2], acc[2 * s][3]); pw.z = pk2(acc[2 * s + 1][0], acc[2 * s + 1][1]); pw.w = pk2(acc[2 * s + 1][2], acc[2 * s + 1][3]);
            const bf16x8 P = __builtin_bit_cast(bf16x8, pw);
#pragma unroll
            for (int df = 0; df < 4; ++df) { const LAS bf16_t* vp = VT + (16 * df + fr) * 272 + 32 * (s_lo + s) + 4 * q;
                const u32x2v lo = *(const LAS u32x2v*)vp, hi = *(const LAS u32x2v*)(vp + 16);
                u32x4v aw; aw.x = lo.x; aw.y = lo.y; aw.z = hi.x; aw.w = hi.y;
                o[df] = MFMA16(__builtin_bit_cast(bf16x8, aw), P, o[df]); }
        }
#pragma unroll
        for (int df = 0; df < 4; ++df) { u32x2v w; w.x = pk2(o[df][0] * inv, o[df][1] * inv); w.y = pk2(o[df][2] * inv, o[df][3] * inv);
            *(u32x2v*)(Y + gt * D + 256 + hq * 64 + 16 * df + 4 * q) = w; }
    }
}
__device__ __forceinline__ void attn_bias_table(const float* rel_bias, LAS unsigned char* lds, int tid) {
    LAS float* BT = (LAS float*)(lds + ATT_BT_OFF);
    for (int idx = tid; idx < 1024; idx += NTHR) { const int h = idx >> 7, dist = idx & 127;
        int bucket = dist;
        if (dist >= 16) bucket = 16 + (dist >= 19) + (dist >= 21) + (dist >= 24) + (dist >= 27) + (dist >= 31) + (dist >= 35) + (dist >= 40) + (dist >= 46) + (dist >= 52) + (dist >= 59) + (dist >= 67) + (dist >= 77) + (dist >= 87) + (dist >= 99) + (dist >= 113);
        BT[idx] = rel_bias[bucket * 8 + h]; }
}

constexpr int LDS_CTL_OFF = 147456 - 256;
#ifndef PROBE_PRE
#define PROBE_PRE 1
#endif
#ifndef PROBE_PREP
#define PROBE_PREP 1
#endif
#ifndef PROBE_P0
#define PROBE_P0 1
#endif
#ifndef PROBE_G1
#define PROBE_G1 1
#endif
#ifndef ATT_IN_PREP
#define ATT_IN_PREP 512
#endif
#ifndef GEMM_SP2
#define GEMM_SP2 true
#endif
#ifndef PROBE_G2
#define PROBE_G2 1
#endif
#ifndef REV_DOWN
#define REV_DOWN 0
#endif
#ifndef PROBE_G3
#define PROBE_G3 1
#endif
#ifndef CONV_LATE
#define CONV_LATE 0
#endif
#ifndef PROBE_LRUFIX
#define PROBE_LRUFIX 1
#endif
#ifndef PROBE_MAIN
#define PROBE_MAIN 1
#endif
#ifndef PROBE_SYNC
#define PROBE_SYNC 0
#endif
struct Args { const float* in[30]; float* out; unsigned char* ws; };
template <class Epi>
__device__ __forceinline__ void run_gemm(LAS unsigned char* lds, const bf16_t* A, const bf16_t* Bt, int N, int K, const Epi& E, int rev = 0, int gsz = 0, int grank = 0) {
    asm volatile("" : "+s"(K), "+s"(N));
    pg8::Gemm g{A, Bt, T, N, K}; pg8::StaticOrder S; S.init(T, N, gsz > 0 ? gsz : (int)gridDim.x, gsz > 0 ? grank : (int)blockIdx.x, rev);
    pg8::gemm_phase<Epi, pg8::StaticOrder, true, GEMM_SP2>(lds, g, S, E);
}
__global__ void __launch_bounds__(NTHR, 2) hymba_fwd(Args args) {
    extern __shared__ __attribute__((aligned(16))) unsigned char lds_raw[];
    LAS unsigned char* lds = (LAS unsigned char*)lds_raw;
    cg::grid_group grid = cg::this_grid();
    const int tid = threadIdx.x, lane = tid & 63, wave = __builtin_amdgcn_readfirstlane(tid >> 6);
    const int G = gridDim.x, bid = blockIdx.x;
    const int gw = bid * NWAVES + wave, ngw = G * NWAVES;
    const float* const* in = args.in;
    unsigned char* ws = args.ws;
    float* out = args.out;
    bf16_t* R1 = (bf16_t*)(ws + WS_R1);
    bf16_t* PBF = (bf16_t*)(ws + WS_R2 + R2_PBF);
    bf16_t* PBUF = (bf16_t*)(ws + WS_R2 + R2_PBUF);
    float* DNBA = (float*)(ws + WS_R2 + R2_DNBA);

    bf16_t* XA = (bf16_t*)(ws + WS_XN);
    bf16_t* YB = (bf16_t*)out;
    bf16_t* XB = (bf16_t*)(ws + WS_R2 + R2_XB);
    float* RSS = (float*)(ws + WS_RSS);
    if (bid == 0) for (int i = tid; i < XCD_BAR_WORDS; i += NTHR) ((unsigned*)ws)[i] = 0u;
    if (tid < 2) ((LAS unsigned*)(lds + LDS_CTL_OFF))[tid] = 0u;
    for (int rep = 0; rep < PROBE_P0; ++rep) {
    convert_weights(in, ws, (LAS float*)(lds + wave * 16384), gw, ngw, lane, 0, NL * CONV_PER_LAYER - CONV_LATE);
    rows_bf16_sumsq(in[0], XA, RSS, gw, ngw, lane);
    }
    grid.sync();
    const XcdBarrier xbar = xcd_barrier_post((unsigned*)ws, (volatile LAS unsigned*)(lds + LDS_CTL_OFF));
#define GSYNC() xcd_barrier(xbar)

    for (int l = 0; l < NL; ++l) {
        const unsigned char* wl = ws + WS_W + (size_t)l * W_LAYER;
        int tid = threadIdx.x; asm volatile("" : "+v"(tid)); int lane = tid & 63;
        const bf16_t* hin = (l == 0) ? XA : XB;
        float* rss0 = RSS, *rss1 = RSS + (size_t)4 * T, *rss2 = RSS, *rss3 = RSS + (size_t)4 * T, *rss4 = RSS;
        LAS float* part = (LAS float*)(lds + EPI_LDS_OFF);
        for (int rep = 0; rep < PROBE_G1; ++rep) {
        { EpiSwiglu E{R1, rss0}; run_gemm(lds, l == 0 ? XA : XB, (const bf16_t*)(wl + O_GU1), 2 * FF, D, E); }
        GSYNC();
        }
        for (int rep = 1; rep < (l == 0 ? PROBE_G2 : 1); ++rep) {
        { EpiResid E{hin, XB, 0.5f, rss1, part}; run_gemm(lds, R1, (const bf16_t*)(wl + O_D1), D, FF, E, REV_DOWN); }
        GSYNC();
        }
        { EpiResid E{hin, XA, 0.5f, rss1, part}; run_gemm(lds, R1, (const bf16_t*)(wl + O_D1), D, FF, E, REV_DOWN); }
        GSYNC();
        for (int rep = 0; rep < PROBE_G3; ++rep) {
        { EpiBf16<NIN, true> E{R1, DNBA, rss1}; run_gemm(lds, XA, (const bf16_t*)(wl + O_IN), NIN, D, E); }
        GSYNC();
        }
        for (int rep = 0; rep < PROBE_PRE; ++rep) {
        for (int it = bid; it < NBATCH * 64; it += G) mixer_pre_item(it, in, l, ws, lds, tid, lane, wave);
        { int t_ = threadIdx.x; asm volatile("" : "+v"(t_)); convert_p(in[1] + (size_t)l * T * PLE, PBF, (size_t)bid * NTHR + t_, (size_t)G * NTHR); }
        GSYNC();
        }
        for (int rep = 0; rep < PROBE_PREP; ++rep) {
            attn_bias_table(in[16], lds, tid);
            for (int b2 = G - 1 - bid; b2 < NBATCH; b2 += G) lru_carry_item(b2, ws, tid);
            for (int it = bid; it < NBATCH * 32; it += G) dn_prep_item(it, ws, lds, tid, lane, wave);
            for (int it = bid; it < ATT_IN_PREP; it += G) attn_item(511 - it, in, l, ws, YB, lds, tid, lane, wave);
            GSYNC();
        }
        for (int rep = 0; rep < PROBE_MAIN; ++rep) {
            if (ATT_IN_PREP < 512) { attn_bias_table(in[16], lds, tid); __syncthreads(); }
            if (G >= 128) {
                if (bid < 64) dn_chain_item(bid, in, l, ws, YB, lds, tid, lane, wave);
                else { const int r = bid - 64, R = G - 64;
                    for (int it = r; it < 512 - ATT_IN_PREP; it += R) attn_item(it, in, l, ws, YB, lds, tid, lane, wave);
                    for (int rep2 = 0; rep2 < PROBE_LRUFIX; ++rep2)
                    for (int it = r; it < NBATCH * 64; it += R) lru_fix_item(it, ws, YB, tid);
                    { __syncthreads(); EpiBf16<D, false> E{PBUF, nullptr, nullptr}; run_gemm(lds, PBF, (const bf16_t*)(wl + O_PP), D, PLE, E, 0, R, r); }
                    if (l == 0 && CONV_LATE > 0) { __syncthreads(); convert_weights(in, ws, (LAS float*)(lds + wave * 16384), r * NWAVES + wave, R * NWAVES, lane, NL * CONV_PER_LAYER - CONV_LATE, NL * CONV_PER_LAYER); }
                }
            } else {
                for (int it = bid; it < 64; it += G) dn_chain_item(it, in, l, ws, YB, lds, tid, lane, wave);
                attn_bias_table(in[16], lds, tid);
                for (int it = bid; it < 512 - ATT_IN_PREP; it += G) attn_item(it, in, l, ws, YB, lds, tid, lane, wave);
                for (int it = bid; it < NBATCH * 64; it += G) lru_fix_item(it, ws, YB, tid);
                { __syncthreads(); EpiBf16<D, false> E{PBUF, nullptr, nullptr}; run_gemm(lds, PBF, (const bf16_t*)(wl + O_PP), D, PLE, E); }
                if (l == 0 && CONV_LATE > 0) { __syncthreads(); convert_weights(in, ws, (LAS float*)(lds + wave * 16384), gw, ngw, lane, NL * CONV_PER_LAYER - CONV_LATE, NL * CONV_PER_LAYER); }
            }
            GSYNC();
        }
        { EpiResid E{XA, XA, 1.0f, rss2, part}; run_gemm(lds, YB, (const bf16_t*)(wl + O_OUT), D, D, E); }
        GSYNC();
        { EpiSwiglu E{R1, rss2}; run_gemm(lds, XA, (const bf16_t*)(wl + O_GU2), 2 * FF, D, E); }
        GSYNC();
        { EpiResid E{XA, XA, 0.5f, rss3, part}; run_gemm(lds, R1, (const bf16_t*)(wl + O_D2), D, FF, E, REV_DOWN); }
        GSYNC();
        { EpiPle E{XA, XB, PBUF, rss3, rss4, part}; run_gemm(lds, XA, (const bf16_t*)(wl + O_PG), D, D, E); }
        GSYNC();
    }
    final_norm_rows(XB, in[29], out, gw, ngw, lane);
}

extern "C" void kernel_launch(void* const* d_in, const int* in_sizes, int n_in, void* d_out, int out_size, void* d_ws, size_t ws_size, hipStream_t stream) {
    static int grid = 0;
    if (grid == 0) {
        if (n_in != 30 || out_size != T * D || ws_size < WS_END) { fprintf(stderr, "kernel_launch: unexpected shapes n_in %d out %d ws %zu (need %zu)\n", n_in, out_size, ws_size, (size_t)WS_END); grid = -1; return; }
        int dev = 0, cus = 0, per_cu = 0;
        (void)hipGetDevice(&dev);
        (void)hipDeviceGetAttribute(&cus, hipDeviceAttributeMultiprocessorCount, dev);
        (void)hipFuncSetAttribute((const void*)hymba_fwd, hipFuncAttributeMaxDynamicSharedMemorySize, LDS_BYTES);
        (void)hipOccupancyMaxActiveBlocksPerMultiprocessor(&per_cu, (const void*)hymba_fwd, NTHR, LDS_BYTES);
        if (per_cu < 1) per_cu = 1;
        (void)hipGetLastError();
        grid = cus * per_cu;
        fprintf(stderr, "kernel_launch: grid %d (cus %d x %d)\n", grid, cus, per_cu);
    }
    if (grid < 0) return;
    Args a{};
    for (int i = 0; i < 30; ++i) a.in[i] = (const float*)d_in[i];
    a.out = (float*)d_out; a.ws = (unsigned char*)d_ws;
    void* kargs[] = {&a};
    hipError_t e = hipLaunchCooperativeKernel((void*)hymba_fwd, dim3(grid), dim3(NTHR), kargs, LDS_BYTES, stream);
    if (e != hipSuccess) fprintf(stderr, "kernel_launch: cooperative launch failed: %s (grid %d)\n", hipGetErrorString(e), grid);
}
```

```cpp
#include <hip/hip_runtime.h>
#include <hip/hip_cooperative_groups.h>
#include <cstdio>
#include <cstdint>
namespace cg = cooperative_groups;
namespace pg8 {
#define PG8_LAS __attribute__((address_space(3)))
typedef unsigned short bf16_t;
typedef short bf16x8 __attribute__((ext_vector_type(8)));
typedef float f32x4 __attribute__((ext_vector_type(4)));
typedef unsigned u32x4 __attribute__((ext_vector_type(4)));
constexpr int BM = 256, BK = 64, HALF = 128, HTB = HALF * BK * 2  , STAGE_BYTES = 8 * HTB, NXCD = 8, WGM = 8;

__host__ __device__ __forceinline__ int lds_byte(int r, int c) { const int st = (r >> 4) * 2 + (c >> 5), rr = r & 15, cc = c & 31, ob = rr * 64 + cc * 2; return st * 1024 + (ob ^ (((ob >> 9) & 1) << 5)); }
__host__ __device__ __forceinline__ void stage_rc(int b, int& R, int& C) { const int st = b / 1024, sb = b % 1024, swz = sb ^ (((sb >> 9) & 1) << 5); R = (st >> 1) * 16 + swz / 64; C = (st & 1) * 32 + (swz % 64) / 2; }
__host__ __device__ __forceinline__ int perm32(int rho) { const int n = rho >> 4, i = rho & 15; return 8 * (i >> 2) + 4 * n + (i & 3); }

struct Unit { int pm, pn; };
struct Gemm { const bf16_t* A; const bf16_t* Bt; int M, N, K; };

struct StaticOrder {
    int nM, nN, nwg, G, c, rev;
    __host__ __device__ void init(int M, int N, int G_, int c_, int rev_ = 0) { nM = M / BM; nN = N / BM; nwg = nM * nN; G = G_; c = c_; rev = rev_; }
    __host__ __device__ bool next(int i, Unit& u) const {
        const long L = (long)i * G + c; if (L >= nwg) return false;
        int wgid = (int)L; { const int q = nwg / NXCD, r = nwg % NXCD, xcd = wgid % NXCD, off = wgid / NXCD; wgid = (xcd < r ? xcd * (q + 1) : r * (q + 1) + (xcd - r) * q) + off; }
        const int nig = WGM * nN, gid = wgid / nig, fm = gid * WGM, gsz = (nM - fm) < WGM ? (nM - fm) : WGM;
        u.pm = fm + ((wgid % nig) % gsz); u.pn = (wgid % nig) / gsz; if (rev) u.pm = nM - 1 - u.pm; return true;
    }
    __device__ __forceinline__ void a_ready(const Unit&) const {}
    __device__ __forceinline__ void done(const Unit&) const {}
};

__device__ __forceinline__ unsigned cvt_pk_bf16(float lo, float hi) { unsigned r; asm volatile("v_cvt_pk_bf16_f32 %0, %1, %2" : "=v"(r) : "v"(lo), "v"(hi)); return r; }
template <class Epi, class Sched, bool ALIGN_EPI = false, bool SP2 = false>
__device__ __forceinline__ void gemm_phase(PG8_LAS unsigned char* lds, const Gemm g, const Sched& S, const Epi& E) {
    int tid_ = threadIdx.x; asm volatile("" : "+v"(tid_));
    const int tid = tid_, wid = __builtin_amdgcn_readfirstlane(tid >> 6), lane = tid & 63, wr = wid >> 2, wc = wid & 3, fr = lane & 15, fq = lane >> 4;
    const int K = g.K, nt = K / BK;
    unsigned voffA[2], voffB[2];
#pragma unroll
    for (int i = 0; i < 2; ++i) { int R, C; stage_rc(tid * 16 + i * 8192, R, C); const int Rb = Epi::PERM ? ((R & ~31) + perm32(R & 31)) : R;
        voffA[i] = (unsigned)(R * K + C) * 2u; voffB[i] = (unsigned)(Rb * K + C) * 2u; }
    const size_t kstep = (size_t)(BK * 2);
    const size_t hstep = (size_t)HALF * K * 2;
    const size_t tstep = 2 * hstep;
    const unsigned ldsw = (unsigned)wid * 1024u;
    const int aoff = lds_byte(wr * 64 + fr, fq * 8), boff = lds_byte(wc * 32 + fr, fq * 8);
#define PG8_SA(b, h) (((b) * 2 + (h)) * HTB)
#define PG8_SB(b, h) ((4 + (b) * 2 + (h)) * HTB)
#define PG8_STAGE(bufoff, gbase, voff) do { _Pragma("unroll") for (int _i = 0; _i < 2; ++_i) \
        __builtin_amdgcn_global_load_lds((const unsigned*)((const char*)(gbase) + (voff)[_i]), (PG8_LAS unsigned*)(lds + (bufoff) + ldsw + _i * 8192), 16, 0, 0); } while (0)
#define PG8_LDA(dst, b, h) do { _Pragma("unroll") for (int m = 0; m < 4; ++m) _Pragma("unroll") for (int k = 0; k < 2; ++k) dst[m][k] = *(const PG8_LAS bf16x8*)(lds + PG8_SA(b, h) + aoff + m * 2048 + k * 1024); } while (0)
#define PG8_LDB(dst, b, h) do { _Pragma("unroll") for (int n = 0; n < 2; ++n) _Pragma("unroll") for (int k = 0; k < 2; ++k) dst[n][k] = *(const PG8_LAS bf16x8*)(lds + PG8_SB(b, h) + boff + n * 2048 + k * 1024); } while (0)
#define PG8_MMA(ai, bj, At, Bt) do { __builtin_amdgcn_s_setprio(1); _Pragma("unroll") for (int m = 0; m < 4; ++m) _Pragma("unroll") for (int n = 0; n < 2; ++n) _Pragma("unroll") for (int k = 0; k < 2; ++k) \
        acc[ai][bj][m][n] = __builtin_amdgcn_mfma_f32_16x16x32_bf16(Bt[n][k], At[m][k], acc[ai][bj][m][n], 0, 0, 0); __builtin_amdgcn_s_setprio(0); } while (0)
#define PG8_WAIT_V(n) asm volatile("s_waitcnt vmcnt(" #n ")" ::: "memory")
#define PG8_WAIT_L(n) asm volatile("s_waitcnt lgkmcnt(" #n ")" ::: "memory")
#define PG8_BAR __builtin_amdgcn_s_barrier()
#define PG8_SCHED __builtin_amdgcn_sched_barrier(0)
    Unit cur, nxt; int ui = 0;
    if (!S.next(0, cur)) return;
    f32x4 acc[2][2][4][2];
#pragma unroll
    for (int a = 0; a < 2; ++a)
#pragma unroll
        for (int b = 0; b < 2; ++b)
#pragma unroll
            for (int m = 0; m < 4; ++m)
#pragma unroll
                for (int n = 0; n < 2; ++n) acc[a][b][m][n] = (f32x4){0.f, 0.f, 0.f, 0.f};
    bf16x8 At[4][2], B0[2][2], B1[2][2];
    const char* cA = (const char*)g.A + (size_t)cur.pm * tstep; const char* cB = (const char*)g.Bt + (size_t)cur.pn * tstep;
    S.a_ready(cur);
    if constexpr (SP2) {
        PG8_STAGE(PG8_SB(0, 0), cB, voffB); PG8_STAGE(PG8_SB(0, 1), cB + hstep, voffB); PG8_STAGE(PG8_SA(0, 0), cA, voffA); PG8_STAGE(PG8_SA(0, 1), cA + hstep, voffA);
        if (wr == 1) PG8_BAR;
        PG8_WAIT_V(2); PG8_BAR;
        PG8_STAGE(PG8_SB(1, 0), cB + kstep, voffB); PG8_STAGE(PG8_SA(1, 0), cA + kstep, voffA); PG8_STAGE(PG8_SB(1, 1), cB + hstep + kstep, voffB);
        PG8_WAIT_V(6); PG8_BAR;
    } else {
        PG8_STAGE(PG8_SB(0, 0), cB, voffB); PG8_STAGE(PG8_SA(0, 0), cA, voffA); PG8_STAGE(PG8_SB(0, 1), cB + hstep, voffB); PG8_STAGE(PG8_SA(0, 1), cA + hstep, voffA);
        if (wr == 1) PG8_BAR;
        PG8_WAIT_V(4); PG8_BAR;
        PG8_STAGE(PG8_SB(1, 0), cB + kstep, voffB); PG8_STAGE(PG8_SA(1, 0), cA + kstep, voffA); PG8_STAGE(PG8_SB(1, 1), cB + hstep + kstep, voffB);
        PG8_WAIT_V(6); PG8_BAR;
    }
    for (;;) {
        const bool has_next = S.next(ui + 1, nxt);
        const char* nA = has_next ? (const char*)g.A + (size_t)nxt.pm * tstep : cA; const char* nB = has_next ? (const char*)g.Bt + (size_t)nxt.pn * tstep : cB;
        for (int t = 0; t < nt; t += 2) {
            const bool last = (t == nt - 2);
            const char* a1 = cA + (size_t)(t + 1) * kstep;
            const char* a2 = last ? nA : cA + (size_t)(t + 2) * kstep; const char* b2 = last ? nB : cB + (size_t)(t + 2) * kstep;
            const char* a3 = a2 + kstep; const char* b3 = b2 + kstep;
            if (last && has_next) S.a_ready(nxt);
            if constexpr (SP2) {
            PG8_LDB(B0, 0, 0); PG8_LDB(B1, 0, 1); PG8_SCHED; PG8_LDA(At, 0, 0); PG8_STAGE(PG8_SA(1, 1), a1 + hstep, voffA);
            PG8_WAIT_V(8); PG8_WAIT_L(0); PG8_BAR; PG8_MMA(0, 0, At, B0); PG8_MMA(0, 1, At, B1); PG8_BAR; PG8_SCHED;
            PG8_LDA(At, 0, 1); PG8_STAGE(PG8_SB(0, 0), b2, voffB); PG8_STAGE(PG8_SB(0, 1), b2 + hstep, voffB); PG8_STAGE(PG8_SA(0, 0), a2, voffA);
            PG8_WAIT_V(8); PG8_WAIT_L(0); PG8_BAR; PG8_MMA(1, 0, At, B0); PG8_MMA(1, 1, At, B1); PG8_BAR; PG8_SCHED;
            PG8_LDB(B0, 1, 0); PG8_LDB(B1, 1, 1); PG8_SCHED; PG8_LDA(At, 1, 0); PG8_STAGE(PG8_SA(0, 1), a2 + hstep, voffA);
            PG8_WAIT_V(8); PG8_WAIT_L(0); PG8_BAR; PG8_MMA(0, 0, At, B0); PG8_MMA(0, 1, At, B1); PG8_BAR; PG8_SCHED;
            PG8_LDA(At, 1, 1); PG8_STAGE(PG8_SB(1, 0), b3, voffB); PG8_STAGE(PG8_SB(1, 1), b3 + hstep, voffB); PG8_STAGE(PG8_SA(1, 0), a3, voffA);
            PG8_WAIT_V(8); PG8_WAIT_L(0); PG8_BAR; PG8_MMA(1, 0, At, B0); PG8_MMA(1, 1, At, B1); PG8_BAR; PG8_SCHED;
            } else {
            PG8_LDB(B0, 0, 0); PG8_SCHED; PG8_LDA(At, 0, 0); PG8_STAGE(PG8_SA(1, 1), a1 + hstep, voffA);
            PG8_WAIT_L(8); PG8_BAR; PG8_WAIT_L(0); PG8_MMA(0, 0, At, B0); PG8_BAR; PG8_SCHED;
            PG8_LDB(B1, 0, 1); PG8_STAGE(PG8_SB(0, 0), b2, voffB);
            PG8_BAR; PG8_WAIT_L(0); PG8_MMA(0, 1, At, B1); PG8_BAR;
            PG8_LDA(At, 0, 1); PG8_STAGE(PG8_SA(0, 0), a2, voffA);
            PG8_BAR; PG8_WAIT_L(0); PG8_MMA(1, 0, At, B0); PG8_BAR; PG8_SCHED;
            PG8_STAGE(PG8_SB(0, 1), b2 + hstep, voffB);
            PG8_WAIT_V(6); PG8_BAR; PG8_MMA(1, 1, At, B1); PG8_BAR;
            PG8_LDB(B0, 1, 0); PG8_SCHED; PG8_LDA(At, 1, 0); PG8_STAGE(PG8_SA(0, 1), a2 + hstep, voffA);
            PG8_WAIT_L(8); PG8_BAR; PG8_WAIT_L(0); PG8_MMA(0, 0, At, B0); PG8_BAR; PG8_SCHED;
            PG8_LDB(B1, 1, 1); PG8_STAGE(PG8_SB(1, 0), b3, voffB);
            PG8_BAR; PG8_WAIT_L(0); PG8_MMA(0, 1, At, B1); PG8_BAR;
            PG8_LDA(At, 1, 1); PG8_STAGE(PG8_SA(1, 0), a3, voffA);
            PG8_BAR; PG8_WAIT_L(0); PG8_MMA(1, 0, At, B0); PG8_BAR; PG8_SCHED;
            PG8_STAGE(PG8_SB(1, 1), b3 + hstep, voffB);
            PG8_WAIT_V(6); PG8_BAR; PG8_MMA(1, 1, At, B1); PG8_BAR;
            }
        }
        if constexpr (ALIGN_EPI) { if (wr == 0) PG8_BAR; }
        if constexpr (!Epi::AFTER_DRAIN) { E(acc, cur, wr, wc, fr, fq); S.done(cur); }
        if (!has_next) break;
#pragma unroll
        for (int a = 0; a < 2; ++a)
#pragma unroll
            for (int b = 0; b < 2; ++b)
#pragma unroll
                for (int m = 0; m < 4; ++m)
#pragma unroll
                    for (int n = 0; n < 2; ++n) acc[a][b][m][n] = (f32x4){0.f, 0.f, 0.f, 0.f};
        cur = nxt; cA = nA; cB = nB; ++ui;
        if constexpr (ALIGN_EPI) { if (wr == 1) PG8_BAR; }
    }
    PG8_WAIT_V(0);
    if constexpr (!ALIGN_EPI) { if (wr == 0) PG8_BAR; }
    PG8_BAR;
    if constexpr (Epi::AFTER_DRAIN) { E.fused(acc, cur, wr, wc, fr, fq, lds, wid, lane); S.done(cur); }
#undef PG8_SA
#undef PG8_SB
#undef PG8_STAGE
#undef PG8_LDA
#undef PG8_LDB
#undef PG8_MMA
#undef PG8_WAIT_V
#undef PG8_WAIT_L
#undef PG8_BAR
#undef PG8_SCHED
}
}

#define LAS __attribute__((address_space(3)))
typedef pg8::bf16_t bf16_t;
typedef pg8::f32x4 f32x4;
typedef pg8::bf16x8 bf16x8;
typedef unsigned u32x4v __attribute__((ext_vector_type(4)));
typedef unsigned u32x2v __attribute__((ext_vector_type(2)));
typedef short s16x4 __attribute__((ext_vector_type(4)));
constexpr int NBATCH = 16, SEQ = 2048, T = NBATCH * SEQ, D = 1024, FF = 2816, DIN = 2312, NIN = 2560, PLE = 256, NL = 2;
constexpr int U_LRUX = 0, U_LRUG = 256, U_AQ = 512, U_AK = 1024, U_AV = 1152, U_DQ = 1280, U_DZ = 2048;
constexpr float EPS = 1e-6f;
constexpr int NTHR = 512, NWAVES = 8;
constexpr int LDS_BYTES = 147456;
constexpr size_t MiB = 1u << 20;
constexpr size_t SZ_GU = 5632ull * 1024 * 2, SZ_DN = 1024ull * 2816 * 2, SZ_IN = 2560ull * 1024 * 2, SZ_SQ = 1024ull * 1024 * 2, SZ_PP = 1024ull * 256 * 2, SZ_LRU = 2ull * 4 * 64 * 64 * 2;
constexpr size_t O_GU1 = 0, O_D1 = O_GU1 + SZ_GU, O_GU2 = O_D1 + SZ_DN, O_D2 = O_GU2 + SZ_GU, O_IN = O_D2 + SZ_DN, O_OUT = O_IN + SZ_IN, O_PG = O_OUT + SZ_SQ, O_PP = O_PG + SZ_SQ, O_LRU = O_PP + SZ_PP, W_LAYER = O_LRU + SZ_LRU;
constexpr size_t WS_W = 1 * MiB, WS_XN = 89 * MiB, WS_R1 = 153 * MiB, WS_R2 = 329 * MiB, WS_END = 512 * MiB;
static_assert(WS_W + NL * W_LAYER <= WS_XN, "weights fit");
static_assert((size_t)T * FF * 2 <= WS_R2 - WS_R1, "act fits R1");
constexpr size_t R2_LH = 0, R2_PC = 16 * MiB, R2_AGG = 32 * MiB, R2_DQ = 34 * MiB, R2_DK = 50 * MiB, R2_DV = 66 * MiB, R2_UU = 82 * MiB, R2_GG = 98 * MiB, R2_BE = 98 * MiB + 512 * 1024, R2_DNBA = 99 * MiB,
                 R2_WW = 100 * MiB, R2_QG = 116 * MiB, R2_ATT = 132 * MiB, R2_KDT = 148 * MiB, R2_EGL = 164 * MiB, R2_USED = 165 * MiB;
constexpr size_t R2_CARRY = 181 * MiB;
static_assert(WS_R2 + R2_CARRY + (size_t)NBATCH * 64 * 256 * 4 <= WS_END, "carry fits");
constexpr size_t WS_UU = WS_R1 + 160 * MiB;
constexpr size_t R2_PBF = 165 * MiB, R2_PBUF = 34 * MiB, R2_XB = 100 * MiB;
static_assert(WS_UU + (size_t)T * 256 * 2 <= WS_R2 && R2_PBUF + (size_t)T * D * 2 <= 98 * MiB && R2_XB + (size_t)T * D * 2 <= 164 * MiB, "map");
constexpr size_t WS_RSS = 87 * MiB;
static_assert(WS_W + NL * W_LAYER <= WS_RSS && WS_RSS + 2 * 4 * (size_t)T * 4 <= WS_XN && R2_PBF + (size_t)T * PLE * 2 <= WS_END - WS_R2, "map");
static_assert(WS_R2 + R2_USED <= WS_END, "R2 fits");

__device__ __forceinline__ float bf2f(unsigned short b) { return __uint_as_float(((unsigned)b) << 16); }
__device__ __forceinline__ float bflo(unsigned w) { return __uint_as_float(w << 16); }
__device__ __forceinline__ float bfhi(unsigned w) { return __uint_as_float(w & 0xffff0000u); }
__device__ __forceinline__ unsigned pk2(float lo, float hi) { return pg8::cvt_pk_bf16(lo, hi); }
__device__ __forceinline__ unsigned short f2bf(float f) { return (unsigned short)(pg8::cvt_pk_bf16(f, 0.f) & 0xffffu); }
__device__ __forceinline__ float sigmoidf_(float x) { return __builtin_amdgcn_rcpf(1.0f + __expf(-x)); }
__device__ __forceinline__ float siluf_(float x) { return x * __builtin_amdgcn_rcpf(1.0f + __expf(-x)); }
__device__ __forceinline__ float softplusf_(float x) { const float e = __expf(-fabsf(x)); const float lg = (e < 0.03f) ? e * (1.0f - e * (0.5f - e * (0.33333334f - 0.25f * e))) : __logf(1.0f + e); return fmaxf(x, 0.f) + lg; }
__device__ __forceinline__ float gelu_tanh(float x) { const float u2 = 1.5957691216057308f * (x + 0.044715f * x * x * x); return x * __builtin_amdgcn_rcpf(1.0f + __expf(-u2)); }
#define DPP_ADD(v, ctrl) do { const int _t = __builtin_amdgcn_update_dpp(0, __builtin_bit_cast(int, (v)), (ctrl), 0xf, 0xf, true); (v) += __builtin_bit_cast(float, _t); } while (0)
__device__ __forceinline__ float wave_sum(float v) {
    DPP_ADD(v, 0xB1); DPP_ADD(v, 0x4E); DPP_ADD(v, 0x141); DPP_ADD(v, 0x140);
    const int vi = __builtin_bit_cast(int, v);
    const float r0 = __builtin_bit_cast(float, __builtin_amdgcn_readlane(vi, 0)), r1 = __builtin_bit_cast(float, __builtin_amdgcn_readlane(vi, 16)), r2 = __builtin_bit_cast(float, __builtin_amdgcn_readlane(vi, 32)), r3 = __builtin_bit_cast(float, __builtin_amdgcn_readlane(vi, 48));
    return (r0 + r1) + (r2 + r3);
}

__device__ __forceinline__ float rstd_of(const float* rss, int row) { const f32x4 p = *(const f32x4*)(rss + (size_t)row * 4); return 1.0f / sqrtf(((p[0] + p[1]) + (p[2] + p[3])) * (1.0f / D) + EPS); }
constexpr int EPI_LDS_OFF = 131072;
using pg8::Unit;
struct EpiSwiglu {
    static constexpr bool PERM = true, AFTER_DRAIN = false;
    bf16_t* O_; const float* rss_;
    __device__ __forceinline__ void operator()(const f32x4 (&acc)[2][2][4][2], const Unit& u, int wr, int wc, int fr, int fq) const {
        bf16_t* O = O_; const float* rss = rss_; asm volatile("" : "+s"(O), "+s"(rss));
        const int row0 = u.pm * 256 + wr * 64 + fr, col0 = u.pn * 128 + wc * 32 + 8 * fq;
        float rsv[2][4];
        { f32x4 pp[2][4];
#pragma unroll
          for (int ai = 0; ai < 2; ++ai)
#pragma unroll
            for (int m = 0; m < 4; ++m) pp[ai][m] = *(const f32x4*)(rss + (size_t)(row0 + ai * 128 + m * 16) * 4);
#pragma unroll
          for (int ai = 0; ai < 2; ++ai)
#pragma unroll
            for (int m = 0; m < 4; ++m) rsv[ai][m] = __builtin_amdgcn_rsqf(((pp[ai][m][0] + pp[ai][m][1]) + (pp[ai][m][2] + pp[ai][m][3])) * (1.0f / D) + EPS); }
#pragma unroll
        for (int ai = 0; ai < 2; ++ai)
#pragma unroll
            for (int m = 0; m < 4; ++m) {
                bf16_t* rowp = O + (size_t)(row0 + ai * 128 + m * 16) * FF + col0;
                const float rs = rsv[ai][m];
                float v[8];
#pragma unroll
                for (int n = 0; n < 2; ++n)
#pragma unroll
                    for (int j = 0; j < 4; ++j) { const float g = acc[ai][0][m][n][j] * rs, up = acc[ai][1][m][n][j] * rs; v[n * 4 + j] = g * __builtin_amdgcn_rcpf(1.0f + __expf(-g)) * up; }
                u32x4v w; w.x = pk2(v[0], v[1]); w.y = pk2(v[2], v[3]); w.z = pk2(v[4], v[5]); w.w = pk2(v[6], v[7]);
                *(u32x4v*)rowp = w;
            }
    }
};
struct EpiResid {
    static constexpr bool PERM = false, AFTER_DRAIN = false;
    const bf16_t* in_; bf16_t* out_; float scale_; float* rss_; LAS float* part;
    __device__ __forceinline__ void operator()(const f32x4 (&acc)[2][2][4][2], const Unit& u, int wr, int wc, int fr, int fq) const {
        const bf16_t* in = in_; bf16_t* out = out_; float scale = scale_; float* rss = rss_;
        asm volatile("" : "+s"(in), "+s"(out), "+s"(scale), "+s"(rss));
        const int row0 = u.pm * 256 + wr * 64 + fr, col0 = u.pn * 256 + wc * 32 + 4 * fq;
#pragma unroll
        for (int hb = 0; hb < 2; ++hb) {
            u32x2v rin[4][4];
#pragma unroll
            for (int gg = 0; gg < 4; ++gg) { const int g = hb * 4 + gg; const size_t offn = (size_t)(row0 + (g >> 2) * 128 + (g & 3) * 16) * D + col0;
#pragma unroll
                for (int k = 0; k < 4; ++k) rin[gg][k] = *(const u32x2v*)(in + offn + (k >> 1) * 128 + (k & 1) * 16); }
#pragma unroll
            for (int gg = 0; gg < 4; ++gg) {
                const int g = hb * 4 + gg, ai = g >> 2, m = g & 3, row = row0 + ai * 128 + m * 16;
                const size_t off = (size_t)row * D + col0;
                float ss = 0.f;
#pragma unroll
                for (int k = 0; k < 4; ++k) { const int bj = k >> 1, n = k & 1; const size_t o = off + bj * 128 + n * 16; const f32x4 a = acc[ai][bj][m][n] * scale; const u32x2v w0 = rin[gg][k];
                    f32x4 r; r[0] = bflo(w0.x) + a[0]; r[1] = bfhi(w0.x) + a[1]; r[2] = bflo(w0.y) + a[2]; r[3] = bfhi(w0.y) + a[3];
                    u32x2v w; w.x = pk2(r[0], r[1]); w.y = pk2(r[2], r[3]); *(u32x2v*)(out + o) = w; ss += (r[0] * r[0] + r[1] * r[1]) + (r[2] * r[2] + r[3] * r[3]); }
                ss += __shfl_xor(ss, 16); ss += __shfl_xor(ss, 32);
                if (fq == 0) part[(ai * 128 + wr * 64 + m * 16 + fr) * 4 + wc] = ss;
            }
        }
        asm volatile("s_waitcnt lgkmcnt(0)" ::: "memory"); __builtin_amdgcn_s_barrier(); asm volatile("" ::: "memory");
        { int t = threadIdx.x; asm volatile("" : "+v"(t)); if (t < 256) { const f32x4 p = *(const LAS f32x4*)(part + t * 4); rss[(size_t)(u.pm * 256 + t) * 4 + u.pn] = (p[0] + p[1]) + (p[2] + p[3]); } }
    }
};
template <int LD, bool SIDE> struct EpiBf16 {
    static constexpr bool PERM = true, AFTER_DRAIN = false;
    bf16_t* O_; float* side_; const float* rss_;
    __device__ __forceinline__ void operator()(const f32x4 (&acc)[2][2][4][2], const Unit& u, int wr, int wc, int fr, int fq) const {
        bf16_t* O = O_; float* side = side_; const float* rss = rss_; asm volatile("" : "+s"(O), "+s"(side), "+s"(rss));
        const int row0 = u.pm * 256 + wr * 64 + fr, col0 = u.pn * 256 + wc * 32 + 8 * fq;
        float rsv[2][4];
        if (SIDE) { f32x4 pp[2][4];
#pragma unroll
          for (int ai = 0; ai < 2; ++ai)
#pragma unroll
            for (int m = 0; m < 4; ++m) pp[ai][m] = *(const f32x4*)(rss + (size_t)(row0 + ai * 128 + m * 16) * 4);
#pragma unroll
          for (int ai = 0; ai < 2; ++ai)
#pragma unroll
            for (int m = 0; m < 4; ++m) rsv[ai][m] = __builtin_amdgcn_rsqf(((pp[ai][m][0] + pp[ai][m][1]) + (pp[ai][m][2] + pp[ai][m][3])) * (1.0f / D) + EPS); }
#pragma unroll
        for (int ai = 0; ai < 2; ++ai)
#pragma unroll
            for (int m = 0; m < 4; ++m) {
                const int row = row0 + ai * 128 + m * 16;
                bf16_t* rowp = O + (size_t)row * LD + col0;
                const float rs = SIDE ? rsv[ai][m] : 1.0f;
#pragma unroll
                for (int bj = 0; bj < 2; ++bj) {
                    const f32x4 v0 = acc[ai][bj][m][0] * rs, v1 = acc[ai][bj][m][1] * rs;
                    u32x4v w; w.x = pk2(v0[0], v0[1]); w.y = pk2(v0[2], v0[3]); w.z = pk2(v1[0], v1[1]); w.w = pk2(v1[2], v1[3]);
                    *(u32x4v*)(rowp + bj * 128) = w;
                    if (SIDE) { if (bj == 0 && u.pn == 9 && wc == 0 && fq == 0) { *(f32x4*)(side + (size_t)row * 8) = v0; *(f32x4*)(side + (size_t)row * 8 + 4) = v1; } }
                }
            }
    }
};
struct EpiPle {
    static constexpr bool PERM = false, AFTER_DRAIN = false;
    const bf16_t* in_; bf16_t* out_; const bf16_t* P_; const float* rss_; float* rss_out_; LAS float* part;
    __device__ __forceinline__ void operator()(const f32x4 (&acc)[2][2][4][2], const Unit& u, int wr, int wc, int fr, int fq) const {
        const bf16_t* in = in_; bf16_t* out = out_; const bf16_t* P = P_; const float* rss = rss_; float* rss_out = rss_out_;
        asm volatile("" : "+s"(in), "+s"(out), "+s"(P), "+s"(rss), "+s"(rss_out));
        const int row0 = u.pm * 256 + wr * 64 + fr, col0 = u.pn * 256 + wc * 32 + 4 * fq;
        float rsv[8];
        { f32x4 pp[8];
#pragma unroll
          for (int g = 0; g < 8; ++g) pp[g] = *(const f32x4*)(rss + (size_t)(row0 + (g >> 2) * 128 + (g & 3) * 16) * 4);
#pragma unroll
          for (int g = 0; g < 8; ++g) rsv[g] = __builtin_amdgcn_rsqf(((pp[g][0] + pp[g][1]) + (pp[g][2] + pp[g][3])) * (1.0f / D) + EPS); }
#pragma unroll
        for (int hb = 0; hb < 4; ++hb) {
            u32x2v rin[2][4], pin[2][4];
#pragma unroll
            for (int gg = 0; gg < 2; ++gg) { const int g = hb * 2 + gg; const size_t offn = (size_t)(row0 + (g >> 2) * 128 + (g & 3) * 16) * D + col0;
#pragma unroll
                for (int k = 0; k < 4; ++k) { const size_t o = offn + (k >> 1) * 128 + (k & 1) * 16; rin[gg][k] = *(const u32x2v*)(in + o); pin[gg][k] = *(const u32x2v*)(P + o); } }
#pragma unroll
            for (int gg = 0; gg < 2; ++gg) {
                const int g = hb * 2 + gg, ai = g >> 2, m = g & 3, row = row0 + ai * 128 + m * 16;
                const size_t off = (size_t)row * D + col0;
                const float rs = rsv[g];
                float ss = 0.f;
#pragma unroll
                for (int k = 0; k < 4; ++k) { const int bj = k >> 1, n = k & 1; const size_t o = off + bj * 128 + n * 16;
                    const u32x2v rw = rin[gg][k], pw = pin[gg][k]; const f32x4 a = acc[ai][bj][m][n] * rs;
                    f32x4 res; res[0] = bflo(rw.x) + sigmoidf_(a[0]) * bflo(pw.x); res[1] = bfhi(rw.x) + sigmoidf_(a[1]) * bfhi(pw.x); res[2] = bflo(rw.y) + sigmoidf_(a[2]) * bflo(pw.y); res[3] = bfhi(rw.y) + sigmoidf_(a[3]) * bfhi(pw.y);
                    u32x2v w; w.x = pk2(res[0], res[1]); w.y = pk2(res[2], res[3]); *(u32x2v*)(out + o) = w; ss += (res[0] * res[0] + res[1] * res[1]) + (res[2] * res[2] + res[3] * res[3]); }
                ss += __shfl_xor(ss, 16); ss += __shfl_xor(ss, 32); if (fq == 0) part[(ai * 128 + wr * 64 + m * 16 + fr) * 4 + wc] = ss;
            }
        }
        asm volatile("s_waitcnt lgkmcnt(0)" ::: "memory"); __builtin_amdgcn_s_barrier(); asm volatile("" ::: "memory");
        { int t = threadIdx.x; asm volatile("" : "+v"(t)); if (t < 256) { const f32x4 p = *(const LAS f32x4*)(part + t * 4); rss_out[(size_t)(u.pm * 256 + t) * 4 + u.pn] = (p[0] + p[1]) + (p[2] + p[3]); } }
    }
};

struct ConvItem { const float* W; const float* gain; bf16_t* WT; int N, ldk, drow0, k0, n0; };
constexpr int CONV_PER_LAYER = 4 * 16 * 88 + 2 * 44 * 32 + 16 * 80 + 2 * 16 * 32 + 4 * 32 + 2 * 8;
__device__ __forceinline__ ConvItem conv_decode(const float* const* in, unsigned char* ws, int it) {
    constexpr int I_GU = 16 * 88, I_DN = 44 * 32, I_IN = 16 * 80, I_SQ = 16 * 32, I_PP = 4 * 32, I_LR = 8;
    static_assert(4 * I_GU + 2 * I_DN + I_IN + 2 * I_SQ + I_PP + 2 * I_LR == CONV_PER_LAYER, "items");
    const int l = it / CONV_PER_LAYER; int r = it % CONV_PER_LAYER;
    unsigned char* wl = ws + WS_W + (size_t)l * W_LAYER;
    ConvItem c;
    if (r < 4 * I_GU) {
        const int which = r / I_GU; r %= I_GU;
        const int kb = r / 88, nb = r % 88, n0 = nb * 32;
        c.W = in[which == 0 ? 3 : which == 1 ? 4 : which == 2 ? 23 : 24] + (size_t)l * D * FF; c.gain = in[which < 2 ? 2 : 22] + l * D; c.WT = (bf16_t*)(wl + (which < 2 ? O_GU1 : O_GU2));
        c.N = FF; c.ldk = D; c.drow0 = (n0 / 128) * 256 + (n0 % 128) + (which & 1) * 128; c.k0 = kb * 64; c.n0 = n0; return c; }
    r -= 4 * I_GU;
    if (r < 2 * I_DN) { const int which = r / I_DN; r %= I_DN; const int kb = r / 32, nb = r % 32;
        c.W = in[which == 0 ? 5 : 25] + (size_t)l * FF * D; c.gain = nullptr; c.WT = (bf16_t*)(wl + (which == 0 ? O_D1 : O_D2)); c.N = D; c.ldk = FF; c.drow0 = nb * 32; c.k0 = kb * 64; c.n0 = nb * 32; return c; }
    r -= 2 * I_DN;
    if (r < I_IN) { const int kb = r / 80, nb = r % 80;
        c.W = in[7] + (size_t)l * D * DIN; c.gain = in[6] + l * D; c.WT = (bf16_t*)(wl + O_IN); c.N = DIN; c.ldk = D; c.drow0 = nb * 32; c.k0 = kb * 64; c.n0 = nb * 32; return c; }
    r -= I_IN;
    if (r < 2 * I_SQ) { const int which = r / I_SQ; r %= I_SQ; const int kb = r / 32, nb = r % 32;
        c.W = in[which == 0 ? 21 : 27] + (size_t)l * D * D; c.gain = which == 0 ? nullptr : in[26] + l * D; c.WT = (bf16_t*)(wl + (which == 0 ? O_OUT : O_PG)); c.N = D; c.ldk = D; c.drow0 = nb * 32; c.k0 = kb * 64; c.n0 = nb * 32; return c; }
    r -= 2 * I_SQ;
    if (r < I_PP) { const int kb = r / 32, nb = r % 32;
        c.W = in[28] + (size_t)l * PLE * D; c.gain = nullptr; c.WT = (bf16_t*)(wl + O_PP); c.N = D; c.ldk = PLE; c.drow0 = nb * 32; c.k0 = kb * 64; c.n0 = nb * 32; return c; }
    r -= I_PP;
    {
        const int which = r / I_LR; r %= I_LR; const int hb = r / 2, nb = r % 2;
        c.W = in[which == 0 ? 10 : 12] + (size_t)l * 4 * 4096 + hb * 4096; c.gain = nullptr; c.WT = (bf16_t*)(wl + O_LRU) + which * 16384 + hb * 4096; c.N = 64; c.ldk = 64; c.drow0 = nb * 32; c.k0 = 0; c.n0 = nb * 32; return c; }
}
__device__ __forceinline__ void conv_load(const ConvItem& c, int lane, float (&v)[32], float (&g)[32]) {
    const int n = c.n0 + (lane & 31); const bool ok = n < c.N;
#pragma unroll
    for (int i = 0; i < 32; ++i) { const int kk = 2 * i + (lane >> 5); v[i] = ok ? c.W[(size_t)(c.k0 + kk) * c.N + n] : 0.f; g[i] = c.gain ? c.gain[c.k0 + kk] : 1.0f; }
}
__device__ __forceinline__ void conv_finish(const ConvItem& c, int lane, const float (&v)[32], const float (&g)[32], LAS float* scr) {
#pragma unroll
    for (int i = 0; i < 32; ++i) { const int kk = 2 * i + (lane >> 5); scr[kk * 33 + (lane & 31)] = v[i] * g[i]; }
    asm volatile("s_waitcnt lgkmcnt(0)" ::: "memory");
    const int cc = lane & 7;
#pragma unroll
    for (int j = 0; j < 4; ++j) { const int n = (lane >> 3) + 8 * j; const LAS float* s = scr + (8 * cc) * 33 + n;
        u32x4v o; o.x = pk2(s[0 * 33], s[1 * 33]); o.y = pk2(s[2 * 33], s[3 * 33]); o.z = pk2(s[4 * 33], s[5 * 33]); o.w = pk2(s[6 * 33], s[7 * 33]);
        *(u32x4v*)(c.WT + (size_t)(c.drow0 + n) * c.ldk + c.k0 + 8 * cc) = o; }
    asm volatile("s_waitcnt lgkmcnt(0)" ::: "memory");
}
__device__ __forceinline__ void convert_weights(const float* const* in, unsigned char* ws, LAS float* scr, int gw, int ngw, int lane, int it_lo, int it_hi) {
    asm volatile("" : "+v"(lane));
    int it = it_lo + gw;
    if (it >= it_hi) return;
    ConvItem cur = conv_decode(in, ws, it);
    float va[32], ga[32], vb[32], gb[32];
    conv_load(cur, lane, va, ga);
    for (;;) {
        const int nx = it + ngw; const bool more = nx < it_hi;
        ConvItem nxt = cur;
        if (more) { nxt = conv_decode(in, ws, nx); conv_load(nxt, lane, vb, gb); }
        conv_finish(cur, lane, va, ga, scr);
        if (!more) break;
#pragma unroll
        for (int i = 0; i < 32; ++i) { va[i] = vb[i]; ga[i] = gb[i]; }
        cur = nxt; it = nx;
    }
}

__device__ __forceinline__ void rows_bf16_sumsq(const float* h, bf16_t* xn, float* rss, int gw, int ngw, int lane) {
    asm volatile("" : "+v"(lane));
    for (int m0 = gw; m0 < T; m0 += 2 * ngw) {
        const int m1 = (m0 + ngw < T) ? m0 + ngw : m0;
        f32x4 va[4], vb[4];
#pragma unroll
        for (int j = 0; j < 4; ++j) { va[j] = __builtin_nontemporal_load((const f32x4*)(h + (size_t)m0 * D) + lane + 64 * j); vb[j] = __builtin_nontemporal_load((const f32x4*)(h + (size_t)m1 * D) + lane + 64 * j); }
#pragma unroll
        for (int rr = 0; rr < 2; ++rr) {
            const int m = rr == 0 ? m0 : m1;
            float s = 0.f;
#pragma unroll
            for (int j = 0; j < 4; ++j) { const f32x4 v = rr == 0 ? va[j] : vb[j]; s += (v[0] * v[0] + v[1] * v[1]) + (v[2] * v[2] + v[3] * v[3]); }
            s = wave_sum(s);
            if (rr == 0 || m1 != m0) {
                u32x2v* o8 = (u32x2v*)(xn + (size_t)m * D) + lane;
#pragma unroll
                for (int j = 0; j < 4; ++j) { const f32x4 v = rr == 0 ? va[j] : vb[j]; u32x2v w; w.x = pk2(v[0], v[1]); w.y = pk2(v[2], v[3]); o8[64 * j] = w; }
                if (lane == 0) *(f32x4*)(rss + (size_t)m * 4) = (f32x4){s, 0.f, 0.f, 0.f};
            }
        }
    }
}
__device__ __forceinline__ void norm_rows_bf16(const float* h, const float* g, bf16_t* xn, int gw, int ngw, int lane) {
    asm volatile("" : "+v"(lane));
    f32x4 gv[4];
#pragma unroll
    for (int j = 0; j < 4; ++j) gv[j] = ((const f32x4*)g)[lane + 64 * j];
    for (int m = gw; m < T; m += ngw) {
        const f32x4* xr = (const f32x4*)(h + (size_t)m * D) + lane;
        f32x4 v[4]; float s = 0.f;
#pragma unroll
        for (int j = 0; j < 4; ++j) { v[j] = xr[64 * j]; s += (v[j][0] * v[j][0] + v[j][1] * v[j][1]) + (v[j][2] * v[j][2] + v[j][3] * v[j][3]); }
        const float rstd = 1.0f / sqrtf(wave_sum(s) * (1.0f / D) + EPS);
        u32x2v* o8 = (u32x2v*)(xn + (size_t)m * D) + lane;
#pragma unroll
        for (int j = 0; j < 4; ++j) { u32x2v w; w.x = pk2(v[j][0] * rstd * gv[j][0], v[j][1] * rstd * gv[j][1]); w.y = pk2(v[j][2] * rstd * gv[j][2], v[j][3] * rstd * gv[j][3]); o8[64 * j] = w; }
    }
}
__device__ __forceinline__ void final_norm_rows(const bf16_t* h, const float* g, float* out, int gw, int ngw, int lane) {
    asm volatile("" : "+v"(lane));
    f32x4 gv[4];
#pragma unroll
    for (int j = 0; j < 4; ++j) gv[j] = ((const f32x4*)g)[lane + 64 * j];
    for (int m0 = gw; m0 < T; m0 += 2 * ngw) {
        const int m1 = (m0 + ngw < T) ? m0 + ngw : m0;
        u32x2v w0[4], w1[4];
#pragma unroll
        for (int j = 0; j < 4; ++j) { w0[j] = ((const u32x2v*)(h + (size_t)m0 * D) + lane)[64 * j]; w1[j] = ((const u32x2v*)(h + (size_t)m1 * D) + lane)[64 * j]; }
#pragma unroll
        for (int rr = 0; rr < 2; ++rr) {
            const int m = rr == 0 ? m0 : m1;
            f32x4 v[4]; float s = 0.f;
#pragma unroll
            for (int j = 0; j < 4; ++j) { const u32x2v w = rr == 0 ? w0[j] : w1[j]; v[j][0] = bflo(w.x); v[j][1] = bfhi(w.x); v[j][2] = bflo(w.y); v[j][3] = bfhi(w.y); s += (v[j][0] * v[j][0] + v[j][1] * v[j][1]) + (v[j][2] * v[j][2] + v[j][3] * v[j][3]); }
            const float rstd = 1.0f / sqrtf(wave_sum(s) * (1.0f / D) + EPS);
            f32x4* o = (f32x4*)(out + (size_t)m * D) + lane;
            if (rr == 0 || m1 != m0) {
#pragma unroll
                for (int j = 0; j < 4; ++j) __builtin_nontemporal_store(v[j] * rstd * gv[j], o + 64 * j);
            }
        }
    }
}
__device__ __forceinline__ void convert_p(const float* p, bf16_t* pbf, size_t gtid, size_t gthreads) {
    asm volatile("" : "+v"(gtid));
    const size_t n8 = (size_t)T * PLE / 8;
    for (size_t i = gtid; i < n8; i += gthreads) { const f32x4 a = ((const f32x4*)p)[2 * i], b = ((const f32x4*)p)[2 * i + 1];
        u32x4v w; w.x = pk2(a[0], a[1]); w.y = pk2(a[2], a[3]); w.z = pk2(b[0], b[1]); w.w = pk2(b[2], b[3]); ((u32x4v*)pbf)[i] = w; }
}

#define MFMA16(a, b, c) __builtin_amdgcn_mfma_f32_16x16x32_bf16((a), (b), (c), 0, 0, 0)

#define XB_TMO      128
#define XB_XCNT(j)  (256  + 64 * (j))
#define XB_XSUB(j)  (1280 + 64 * (j))
#define XB_XGEN(j)  (2304 + 64 * (j))
#define XB_TOP      3328
#define XB_TOPGEN   3392
#define XCD_BAR_WORDS 3456
#define XB_SPIN_CAP (1u << 18)

__device__ __forceinline__ unsigned xb_ld(unsigned* p)              { return __hip_atomic_load(p, __ATOMIC_RELAXED, __HIP_MEMORY_SCOPE_AGENT); }
__device__ __forceinline__ unsigned xb_add(unsigned* p, unsigned v) { return __hip_atomic_fetch_add(p, v, __ATOMIC_RELAXED, __HIP_MEMORY_SCOPE_AGENT); }
__device__ __forceinline__ unsigned xb_xcc_id() { return (unsigned)__builtin_amdgcn_s_getreg((3 << 11) | 20) & 0xFu; }
#define XB_SPIN(cond, bar) do { unsigned _sp = 0; while (cond) { __builtin_amdgcn_s_sleep(8); \
    if ((++_sp & 255u) == 0u) { if (xb_ld(&(bar)[XB_TMO])) break; if (_sp > XB_SPIN_CAP) { atomicAdd(&(bar)[XB_TMO], 1u); break; } } } } while (0)

struct XcdBarrier {
    unsigned* bar; unsigned x;
    volatile LAS unsigned* st;
};

__device__ __forceinline__ XcdBarrier xcd_barrier_post(unsigned* bar, volatile LAS unsigned* st) {
    XcdBarrier b; b.bar = bar; b.x = xb_xcc_id(); b.st = st;
    if (threadIdx.x == 0) (void)xb_add(&bar[XB_XCNT(b.x)], 1u);
    return b;
}
__device__ __forceinline__ void xcd_barrier_complete(unsigned* bar, unsigned x, unsigned& nloc, unsigned& nx) {
    const unsigned G = gridDim.x * gridDim.y * gridDim.z;
    unsigned sum, cnt, mine, sp = 0u;
    for (;;) {
        sum = 0u; cnt = 0u; mine = 0u;
#pragma unroll
        for (unsigned j = 0; j < 16; ++j) { const unsigned c = xb_ld(&bar[XB_XCNT(j)]); sum += c; cnt += (c > 0u) ? 1u : 0u; mine = (j == x) ? c : mine; }
        if (sum == G) break;
        __builtin_amdgcn_s_sleep(1);
        if ((++sp & 255u) == 0u) { if (xb_ld(&bar[XB_TMO])) break; if (sp > XB_SPIN_CAP) { atomicAdd(&bar[XB_TMO], 1u); break; } }
    }
    nloc = mine > 0u ? mine : 1u; nx = cnt > 0u ? cnt : 1u;
}

__device__ __forceinline__ void xcd_barrier(const XcdBarrier& b) {
    asm volatile("s_waitcnt vmcnt(0)" ::: "memory");
    __syncthreads();
    if (threadIdx.x == 0) {
        unsigned* bar = b.bar;
        __builtin_amdgcn_s_waitcnt(0);
        unsigned nloc = b.st[0], nx = b.st[1];
        if (nloc == 0u) { xcd_barrier_complete(bar, b.x, nloc, nx); b.st[0] = nloc; b.st[1] = nx; }
        const unsigned old = xb_add(&bar[XB_XSUB(b.x)], 1u);
        const unsigned gen = old / nloc;
        if (old + 1u == (gen + 1u) * nloc) {
            __builtin_amdgcn_fence(__ATOMIC_RELEASE, "agent");
            asm volatile("s_waitcnt vmcnt(0)" ::: "memory");
            const unsigned og = xb_add(&bar[XB_TOP], 1u);
            const unsigned tg = og / nx;
            if (og + 1u == (tg + 1u) * nx) xb_add(&bar[XB_TOPGEN], 1u);
            else XB_SPIN(xb_ld(&bar[XB_TOPGEN]) == tg, bar);
            __builtin_amdgcn_fence(__ATOMIC_ACQUIRE, "agent");
            xb_add(&bar[XB_XGEN(b.x)], 1u);
            asm volatile("s_waitcnt vmcnt(0)" ::: "memory");
        } else {
            XB_SPIN(xb_ld(&bar[XB_XGEN(b.x)]) == gen, bar);
            __builtin_amdgcn_fence(__ATOMIC_ACQUIRE, "agent");
            asm volatile("s_waitcnt vmcnt(0)" ::: "memory");
        }
    }
    __syncthreads();
}


__device__ __forceinline__ void mixer_pre_item(int item, const float* const* in, int l, unsigned char* ws, LAS unsigned char* lds, int tid, int lane, int wave) {
    asm volatile("" : "+v"(tid)); lane = tid & 63; wave = __builtin_amdgcn_readfirstlane(tid >> 6);
    const int b = item >> 6, c = item & 63, s0 = c * 32;
    const size_t g0 = (size_t)b * SEQ + s0;
    const bf16_t* U = (const bf16_t*)(ws + WS_R1);
    LAS bf16_t* STGL = (LAS bf16_t*)lds;
    LAS bf16_t* STGD = (LAS bf16_t*)(lds + 17920);
    LAS float* XRF = (LAS float*)(lds + 17920);
    LAS float* AF = (LAS float*)(lds + 50688);
    LAS bf16_t* XRB = (LAS bf16_t*)(lds + 83456);
    __syncthreads();
#pragma unroll
    for (int i = 0; i < 9; ++i) { const int id = tid + 512 * i;
        if (id < 35 * 128) { const int row = id >> 7, pc = id & 127, s = s0 - 3 + row;
            u32x4v v = (u32x4v){0u, 0u, 0u, 0u};
            if (s >= 0) v = *(const u32x4v*)(U + ((size_t)b * SEQ + s) * NIN + (pc < 32 ? pc * 8 : U_DQ + (pc - 32) * 8));
            if (pc < 32) *(LAS u32x4v*)(STGL + row * 256 + pc * 8) = v; else *(LAS u32x4v*)(STGD + row * 768 + (pc - 32) * 8) = v; } }
    __syncthreads();
    for (int task = wave; task < 24; task += 8) {
        const int g = task >> 1, t0 = (task & 1) * 16, kind = g >> 2, hh = g & 3, cc = g * 64 + lane;
        const float* cw = in[17] + (size_t)l * 4 * 768;
        const float w0 = cw[cc], w1 = cw[768 + cc], w2 = cw[1536 + cc], w3 = cw[2304 + cc];
        bf16_t* dst = (bf16_t*)(ws + WS_R2 + (kind == 0 ? R2_DQ : kind == 1 ? R2_DK : R2_DV)) + (g0 + t0) * 256 + hh * 64 + lane;
        float xm3 = bf2f(STGD[t0 * 768 + cc]), xm2 = bf2f(STGD[(t0 + 1) * 768 + cc]), xm1 = bf2f(STGD[(t0 + 2) * 768 + cc]);
        const float qs = (kind == 0) ? 0.125f : 1.0f;
#pragma unroll 8
        for (int t = 0; t < 16; ++t) { const float xc = bf2f(STGD[(t0 + t + 3) * 768 + cc]); float y = siluf_(w0 * xm3 + w1 * xm2 + w2 * xm1 + w3 * xc);
            if (kind < 2) { const float ss = wave_sum(y * y); y *= qs * __builtin_amdgcn_rsqf(ss + EPS); }
            dst[(size_t)t * 256] = f2bf(y);
            xm3 = xm2; xm2 = xm1; xm1 = xc; }
    }
    if (tid < 128) { const int tok = tid >> 2, hh = tid & 3; const float* sd = (const float*)(ws + WS_R2 + R2_DNBA) + (g0 + tok) * 8;
        const float beta = sigmoidf_(sd[hh]), g = -__expf(in[18][l * 4 + hh]) * softplusf_(sd[4 + hh] + in[19][l * 4 + hh]);
        ((float*)(ws + WS_R2 + R2_GG))[(g0 + tok) * 4 + hh] = g; ((float*)(ws + WS_R2 + R2_BE))[(g0 + tok) * 4 + hh] = beta; }
    __syncthreads();
    {
        const int ch = tid & 255, t0 = (tid >> 8) * 16;
        const float* cw = in[8] + (size_t)l * 4 * 256;
        const float w0 = cw[ch], w1 = cw[256 + ch], w2 = cw[512 + ch], w3 = cw[768 + ch], bb = in[9][l * 256 + ch];
        float xm3 = bf2f(STGL[t0 * 256 + ch]), xm2 = bf2f(STGL[(t0 + 1) * 256 + ch]), xm1 = bf2f(STGL[(t0 + 2) * 256 + ch]);
#pragma unroll 8
        for (int i = 0; i < 16; ++i) { const float xc = bf2f(STGL[(t0 + i + 3) * 256 + ch]); const float xr = w0 * xm3 + w1 * xm2 + w2 * xm1 + w3 * xc + bb;
            XRF[(t0 + i) * 256 + ch] = xr; XRB[(t0 + i) * 264 + ch] = f2bf(xr); xm3 = xm2; xm2 = xm1; xm1 = xc; }
    }
    __syncthreads();
    {
        const int hb = wave & 3, mf = wave >> 2, fr = lane & 15, q = lane >> 4;
        const bf16_t* WTa = (const bf16_t*)(ws + WS_W + (size_t)l * W_LAYER + O_LRU) + hb * 4096;
        const bf16_t* WTx = WTa + 16384;
        f32x4 aa[4], ax[4];
#pragma unroll
        for (int nf = 0; nf < 4; ++nf) { aa[nf] = (f32x4){0.f, 0.f, 0.f, 0.f}; ax[nf] = (f32x4){0.f, 0.f, 0.f, 0.f}; }
#pragma unroll
        for (int ks = 0; ks < 2; ++ks) {
            const bf16x8 A = *(const LAS bf16x8*)(XRB + (16 * mf + fr) * 264 + 64 * hb + 32 * ks + 8 * q);
#pragma unroll
            for (int nf = 0; nf < 4; ++nf) {
                const bf16x8 Ba = *(const bf16x8*)(WTa + (16 * nf + fr) * 64 + 32 * ks + 8 * q), Bx = *(const bf16x8*)(WTx + (16 * nf + fr) * 64 + 32 * ks + 8 * q);
                aa[nf] = MFMA16(A, Ba, aa[nf]); ax[nf] = MFMA16(A, Bx, ax[nf]); }
        }
#pragma unroll
        for (int nf = 0; nf < 4; ++nf) {
            const int ch = 64 * hb + 16 * nf + fr;
            const float ba = in[11][l * 256 + ch], bx = in[13][l * 256 + ch], sp = softplusf_(-in[14][l * 256 + ch]);
#pragma unroll
            for (int jj = 0; jj < 4; ++jj) { const int tok = 16 * mf + 4 * q + jj;
                const float r = sigmoidf_(aa[nf][jj] + ba), ig = sigmoidf_(ax[nf][jj] + bx), la = -8.0f * r * sp, a = __expf(la), x2 = 2.0f * la;
                const float om = (x2 > -0.25f) ? -x2 * (1.0f + x2 * (0.5f + x2 * (0.16666667f + x2 * (0.041666668f + x2 * (0.008333334f + x2 * 0.0013888889f))))) : 1.0f - a * a;
                const float mult = sqrtf(om);
                const float xr = XRF[tok * 256 + ch]; AF[tok * 256 + ch] = a; XRF[tok * 256 + ch] = mult * ig * xr; }
        }
    }
    __syncthreads();
    if (tid < 256) {
        float h = 0.f, P = 1.f;
        bf16_t* LH = (bf16_t*)(ws + WS_R2 + R2_LH) + g0 * 256 + tid; bf16_t* PC = (bf16_t*)(ws + WS_R2 + R2_PC) + g0 * 256 + tid;
#pragma unroll 8
        for (int t = 0; t < 32; ++t) { const float a = AF[t * 256 + tid], uu = XRF[t * 256 + tid]; h = a * h + uu; P *= a; LH[t * 256] = f2bf(h); PC[t * 256] = f2bf(P); }
        float2 ag; ag.x = P; ag.y = h; ((float2*)(ws + WS_R2 + R2_AGG))[(size_t)(b * 64 + c) * 256 + tid] = ag;
    }
}

__device__ __forceinline__ void dn_prep_item(int item, unsigned char* ws, LAS unsigned char* lds, int tid, int lane, int wave) {
    asm volatile("" : "+v"(tid)); lane = tid & 63; wave = __builtin_amdgcn_readfirstlane(tid >> 6);
    const int b = item >> 5, c = item & 31;
    const size_t tok0 = (size_t)b * SEQ + c * 64;
    LAS float* LM = (LAS float*)lds;
    LAS float* GC = (LAS float*)(lds + 65536);
    LAS float* BES = (LAS float*)(lds + 65536 + 2048);
    const bf16_t* DQ = (const bf16_t*)(ws + WS_R2 + R2_DQ); const bf16_t* DK = (const bf16_t*)(ws + WS_R2 + R2_DK);
    const bf16_t* DV = (const bf16_t*)(ws + WS_R2 + R2_DV); bf16_t* UUo = (bf16_t*)(ws + WS_UU);
    bf16_t* WW = (bf16_t*)(ws + WS_R2 + R2_WW); bf16_t* QG = (bf16_t*)(ws + WS_R2 + R2_QG); bf16_t* ATT = (bf16_t*)(ws + WS_R2 + R2_ATT); bf16_t* KDT = (bf16_t*)(ws + WS_R2 + R2_KDT);
    const int hd = wave >> 1, half = wave & 1, fr = lane & 15, q = lane >> 4;
    __syncthreads();
    float gc = ((const float*)(ws + WS_R2 + R2_GG))[(tok0 + lane) * 4 + hd];
    const float be_l = ((const float*)(ws + WS_R2 + R2_BE))[(tok0 + lane) * 4 + hd];
    bf16x8 Bk[4][2], Aq[2][2];
#pragma unroll
    for (int cf = 0; cf < 4; ++cf)
#pragma unroll
        for (int ks = 0; ks < 2; ++ks) Bk[cf][ks] = *(const bf16x8*)(DK + (tok0 + 16 * cf + fr) * 256 + hd * 64 + 32 * ks + 8 * q);
    bf16x8 Ak[2][2], Kd[4];
#pragma unroll
    for (int r2 = 0; r2 < 2; ++r2)
#pragma unroll
        for (int ks = 0; ks < 2; ++ks) { Aq[r2][ks] = *(const bf16x8*)(DQ + (tok0 + 16 * (2 * half + r2) + fr) * 256 + hd * 64 + 32 * ks + 8 * q); Ak[r2][ks] = *(const bf16x8*)(DK + (tok0 + 16 * (2 * half + r2) + fr) * 256 + hd * 64 + 32 * ks + 8 * q); }
#pragma unroll
    for (int cf = 0; cf < 4; ++cf) Kd[cf] = *(const bf16x8*)(DK + (tok0 + 16 * cf + fr) * 256 + hd * 64 + 32 * half + 8 * q);
    {
#pragma unroll
        for (int o = 1; o < 64; o <<= 1) { const float t = __shfl_up(gc, o); if (lane >= o) gc += t; }
        const float glast = __shfl(gc, 63);
        GC[wave * 64 + lane] = gc; BES[wave * 64 + lane] = be_l;
        if (half == 0 && lane == 0) ((float*)(ws + WS_R2 + R2_EGL))[(size_t)(b * 32 + c) * 4 + hd] = __expf(glast);
        asm volatile("s_waitcnt lgkmcnt(0)" ::: "memory");
        float gjv[4], giv[2][4], biv[2][4];
#pragma unroll
        for (int cf = 0; cf < 4; ++cf) gjv[cf] = GC[wave * 64 + 16 * cf + fr];
#pragma unroll
        for (int r2 = 0; r2 < 2; ++r2)
#pragma unroll
            for (int jj = 0; jj < 4; ++jj) { const int i = 16 * (2 * half + r2) + 4 * q + jj; giv[r2][jj] = GC[wave * 64 + i]; biv[r2][jj] = BES[wave * 64 + i]; }
        const float sc_q0 = __expf(GC[wave * 64 + 16 * (2 * half) + fr]), sc_q1 = __expf(GC[wave * 64 + 16 * (2 * half + 1) + fr]);
#pragma unroll
        for (int r2 = 0; r2 < 2; ++r2) { const int rf = 2 * half + r2;
#pragma unroll
            for (int cf = 0; cf < 4; ++cf) {
                f32x4 kk = (f32x4){0.f, 0.f, 0.f, 0.f}, qk = (f32x4){0.f, 0.f, 0.f, 0.f};
#pragma unroll
                for (int ks = 0; ks < 2; ++ks) { kk = MFMA16(Ak[r2][ks], Bk[cf][ks], kk); qk = MFMA16(Aq[r2][ks], Bk[cf][ks], qk); }
                const int j = 16 * cf + fr; const float gj = gjv[cf];
#pragma unroll
                for (int jj = 0; jj < 4; ++jj) { const int i = 16 * rf + 4 * q + jj; const float gi = giv[r2][jj], bi = biv[r2][jj];
                    const float dec = (j <= i) ? __expf(gi - gj) : 0.f;
                    LM[(hd * 64 + i) * 64 + j] = (j < i) ? bi * kk[jj] * dec : 0.f;
                    ATT[(tok0 + i) * 256 + hd * 64 + j] = f2bf(qk[jj] * dec); }
            }
        }
#pragma unroll
        for (int r2 = 0; r2 < 2; ++r2) { const int iq = 16 * (2 * half + r2) + fr; const float sc = r2 == 0 ? sc_q0 : sc_q1;
#pragma unroll
            for (int ks = 0; ks < 2; ++ks) { const u32x4v w = __builtin_bit_cast(u32x4v, Aq[r2][ks]);
                u32x4v r; r.x = pk2(bflo(w.x) * sc, bfhi(w.x) * sc); r.y = pk2(bflo(w.y) * sc, bfhi(w.y) * sc); r.z = pk2(bflo(w.z) * sc, bfhi(w.z) * sc); r.w = pk2(bflo(w.w) * sc, bfhi(w.w) * sc);
                *(u32x4v*)(QG + (tok0 + iq) * 256 + hd * 64 + 32 * ks + 8 * q) = r; } }
#pragma unroll
        for (int cf = 0; cf < 4; ++cf) { const int cj = 16 * cf + fr; const float sc = __expf(glast - gjv[cf]);
            const u32x4v w = __builtin_bit_cast(u32x4v, Kd[cf]);
            bf16_t* dp = KDT + (tok0 + 32 * half + 8 * q) * 256 + hd * 64 + cj;
            dp[0 * 256] = f2bf(bflo(w.x) * sc); dp[1 * 256] = f2bf(bfhi(w.x) * sc); dp[2 * 256] = f2bf(bflo(w.y) * sc); dp[3 * 256] = f2bf(bfhi(w.y) * sc);
            dp[4 * 256] = f2bf(bflo(w.z) * sc); dp[5 * 256] = f2bf(bfhi(w.z) * sc); dp[6 * 256] = f2bf(bflo(w.w) * sc); dp[7 * 256] = f2bf(bfhi(w.w) * sc); }
    }
    unsigned short xr[64];
    { const bf16_t* src = (half == 0 ? DV : DK) + tok0 * 256 + hd * 64 + lane;
#pragma unroll
      for (int i = 0; i < 64; ++i) xr[i] = src[(size_t)i * 256]; }
    __syncthreads();
    {
        const int col = lane;
        float x[64];
#ifdef PROBE_PHB
        for (int rep_ = 0; rep_ < PROBE_PHB; ++rep_) { asm volatile("" ::: "memory");
#endif
        const LAS float* bes = BES + (hd * 2) * 64; const LAS float* gcs = GC + (hd * 2) * 64;
        if (half == 0) {
#pragma unroll
            for (int i = 0; i < 64; ++i) x[i] = bf2f(xr[i]) * bes[i];
        } else {
#pragma unroll
            for (int i = 0; i < 64; ++i) x[i] = bf2f(xr[i]) * bes[i] * __expf(gcs[i]);
        }
        const LAS float* Lh = LM + hd * 4096;
#pragma unroll
        for (int i = 1; i < 64; ++i) {
            float acc = x[i];
#pragma unroll
            for (int j4 = 0; j4 < (i + 3) / 4; ++j4) { const f32x4 lv = *(const LAS f32x4*)(Lh + i * 64 + 4 * j4);
#pragma unroll
                for (int jj = 0; jj < 4; ++jj) if (4 * j4 + jj < i) acc -= lv[jj] * x[4 * j4 + jj]; }
            x[i] = acc;
        }
#ifdef PROBE_PHB
        asm volatile("" : "+v"(x[63])); }
#endif
        if (half == 0) {
#pragma unroll
            for (int i = 0; i < 64; ++i) UUo[(tok0 + i) * 256 + hd * 64 + col] = f2bf(x[i]);
        } else {
#pragma unroll
            for (int i = 0; i < 64; ++i) WW[(tok0 + i) * 256 + hd * 64 + col] = f2bf(x[i]);
        }
    }
}
__device__ __forceinline__ void dn_chain_item(int item, const float* const* in, int l, unsigned char* ws, bf16_t* ybuf, LAS unsigned char* lds, int tid, int lane, int wave) {
    asm volatile("" : "+v"(tid)); lane = tid & 63; wave = __builtin_amdgcn_readfirstlane(tid >> 6);
    const int b = item >> 2, hd = item & 3;
    LAS bf16_t* Wl = (LAS bf16_t*)lds; LAS bf16_t* QGl = Wl + 64 * 72; LAS bf16_t* ATl = QGl + 64 * 72; LAS bf16_t* KDl = ATl + 64 * 72;
    LAS bf16_t* UUl = (LAS bf16_t*)(lds + 36864); LAS float* OSl = (LAS float*)(lds + 53248);
    const bf16_t* WW = (const bf16_t*)(ws + WS_R2 + R2_WW); const bf16_t* QG = (const bf16_t*)(ws + WS_R2 + R2_QG); const bf16_t* ATT = (const bf16_t*)(ws + WS_R2 + R2_ATT); const bf16_t* KDT = (const bf16_t*)(ws + WS_R2 + R2_KDT);
    const bf16_t* UUg = (const bf16_t*)(ws + WS_UU); const float* EGL = (const float*)(ws + WS_R2 + R2_EGL);
    const bf16_t* U = (const bf16_t*)(ws + WS_R1); bf16_t* Y = ybuf;
    const int lr = tid >> 3, lp = tid & 7, fr = lane & 15, q = lane >> 4, ef = wave;
    const int orow = (tid & 255) >> 2, op = tid & 3;
    const size_t base = (size_t)b * SEQ * 256 + hd * 64;
    f32x4 Sacc[4];
#pragma unroll
    for (int df = 0; df < 4; ++df) Sacc[df] = (f32x4){0.f, 0.f, 0.f, 0.f};
    u32x4v rwA, rqA, raA, rkA, ruA, rz0A, rz1A, rwB, rqB, raB, rkB, ruB, rz0B, rz1B, pz0, pz1;
    rz0A = (u32x4v){0u, 0u, 0u, 0u}; rz1A = rz0A; rz0B = rz0A; rz1B = rz0A;
    pz0 = (u32x4v){0u, 0u, 0u, 0u}; pz1 = pz0;
#define DN_LOAD(cc, S) do { const size_t o = base + (size_t)((cc) * 64 + lr) * 256 + lp * 8; rw##S = *(const u32x4v*)(WW + o); rq##S = *(const u32x4v*)(QG + o); ra##S = *(const u32x4v*)(ATT + o); rk##S = *(const u32x4v*)(KDT + o); \
        ru##S = *(const u32x4v*)(UUg + o); \
        if (wave >= 4) { const bf16_t* zp = U + ((size_t)b * SEQ + (cc) * 64 + orow) * NIN + U_DZ + hd * 64 + op * 16; rz0##S = *(const u32x4v*)zp; rz1##S = *(const u32x4v*)(zp + 8); } } while (0)
#define DN_OUT(cc, zA, zB) do { const LAS float* os = OSl + ((cc) & 1) * 4096 + orow * 64 + op * 16; const f32x4 o0 = *(const LAS f32x4*)os, o1 = *(const LAS f32x4*)(os + 4), o2 = *(const LAS f32x4*)(os + 8), o3 = *(const LAS f32x4*)(os + 12); \
        float ss = (o0[0] * o0[0] + o0[1] * o0[1]) + (o0[2] * o0[2] + o0[3] * o0[3]) + (o1[0] * o1[0] + o1[1] * o1[1]) + (o1[2] * o1[2] + o1[3] * o1[3]) + (o2[0] * o2[0] + o2[1] * o2[1]) + (o2[2] * o2[2] + o2[3] * o2[3]) + (o3[0] * o3[0] + o3[1] * o3[1]) + (o3[2] * o3[2] + o3[3] * o3[3]); \
        ss += __shfl_xor(ss, 1); ss += __shfl_xor(ss, 2); \
        const float rs = 1.0f / sqrtf(ss * (1.0f / 64.0f) + EPS); \
        const f32x4 n0 = nwA * rs, n1 = nwB * rs, n2 = nwC * rs, n3 = nwD * rs; \
        u32x4v w0, w1; \
        w0.x = pk2(o0[0] * n0[0] * siluf_(bflo(zA.x)), o0[1] * n0[1] * siluf_(bfhi(zA.x))); w0.y = pk2(o0[2] * n0[2] * siluf_(bflo(zA.y)), o0[3] * n0[3] * siluf_(bfhi(zA.y))); \
        w0.z = pk2(o1[0] * n1[0] * siluf_(bflo(zA.z)), o1[1] * n1[1] * siluf_(bfhi(zA.z))); w0.w = pk2(o1[2] * n1[2] * siluf_(bflo(zA.w)), o1[3] * n1[3] * siluf_(bfhi(zA.w))); \
        w1.x = pk2(o2[0] * n2[0] * siluf_(bflo(zB.x)), o2[1] * n2[1] * siluf_(bfhi(zB.x))); w1.y = pk2(o2[2] * n2[2] * siluf_(bflo(zB.y)), o2[3] * n2[3] * siluf_(bfhi(zB.y))); \
        w1.z = pk2(o3[0] * n3[0] * siluf_(bflo(zB.z)), o3[1] * n3[1] * siluf_(bfhi(zB.z))); w1.w = pk2(o3[2] * n3[2] * siluf_(bflo(zB.w)), o3[3] * n3[3] * siluf_(bfhi(zB.w))); \
        bf16_t* yp = Y + ((size_t)b * SEQ + (cc) * 64 + orow) * D + 768 + hd * 64 + op * 16; *(u32x4v*)yp = w0; *(u32x4v*)(yp + 8) = w1; } while (0)
    const float* nwp = in[20] + l * 64 + op * 16; const f32x4 nwA = *(const f32x4*)nwp, nwB = *(const f32x4*)(nwp + 4), nwC = *(const f32x4*)(nwp + 8), nwD = *(const f32x4*)(nwp + 12);
#define DN_FRAG(P, row, s) ({ const LAS bf16_t* _p = (P) + (row) * 72 + 32 * (s) + 4 * q; const u32x2v _lo = *(const LAS u32x2v*)_p, _hi = *(const LAS u32x2v*)(_p + 16); u32x4v _w; _w.x = _lo.x; _w.y = _lo.y; _w.z = _hi.x; _w.w = _hi.y; __builtin_bit_cast(bf16x8, _w); })
#define DN_BODY(c, S) do { \
        *(LAS u32x4v*)(Wl + lr * 72 + lp * 8) = rw##S; *(LAS u32x4v*)(QGl + lr * 72 + lp * 8) = rq##S; *(LAS u32x4v*)(ATl + lr * 72 + lp * 8) = ra##S; *(LAS u32x4v*)(KDl + lr * 72 + lp * 8) = rk##S; \
        *(LAS u32x4v*)(UUl + lr * 72 + lp * 8) = ru##S; \
        const u32x4v cz0 = pz0, cz1 = pz1; \
        pz0 = rz0##S; pz1 = rz1##S; \
        const float egl = egl_n; egl_n = EGL[(size_t)(b * 32 + (c + 1 < 32 ? c + 1 : c)) * 4 + hd]; \
        __syncthreads(); \
        if (c + 2 < 32) DN_LOAD(c + 2, S); \
        if (wave < 4) { \
            LAS float* OSc = OSl + (c & 1) * 4096; \
            bf16x8 fr_[4][2]; float uu[4][4]; \
            bf16x8 Sb[2], Vb[2]; \
_Pragma("unroll") \
            for (int s = 0; s < 2; ++s) { u32x4v w; w.x = pk2(Sacc[2 * s][0], Sacc[2 * s][1]); w.y = pk2(Sacc[2 * s][2], Sacc[2 * s][3]); w.z = pk2(Sacc[2 * s + 1][0], Sacc[2 * s + 1][1]); w.w = pk2(Sacc[2 * s + 1][2], Sacc[2 * s + 1][3]); Sb[s] = __builtin_bit_cast(bf16x8, w); } \
            f32x4 vn[4], oo[4]; \
_Pragma("unroll") \
            for (int cf = 0; cf < 4; ++cf) \
_Pragma("unroll") \
                for (int s = 0; s < 2; ++s) fr_[cf][s] = DN_FRAG(Wl, 16 * cf + fr, s); \
_Pragma("unroll") \
            for (int cf = 0; cf < 4; ++cf) \
_Pragma("unroll") \
                for (int jj = 0; jj < 4; ++jj) uu[cf][jj] = bf2f(UUl[(16 * cf + 4 * q + jj) * 72 + 16 * ef + fr]); \
_Pragma("unroll") \
            for (int cf = 0; cf < 4; ++cf) { f32x4 a = (f32x4){0.f, 0.f, 0.f, 0.f}; a = MFMA16(fr_[cf][0], Sb[0], a); a = MFMA16(fr_[cf][1], Sb[1], a); vn[cf] = a; } \
_Pragma("unroll") \
            for (int cf = 0; cf < 4; ++cf) \
_Pragma("unroll") \
                for (int s = 0; s < 2; ++s) fr_[cf][s] = DN_FRAG(QGl, 16 * cf + fr, s); \
_Pragma("unroll") \
            for (int cf = 0; cf < 4; ++cf) { f32x4 a = (f32x4){0.f, 0.f, 0.f, 0.f}; a = MFMA16(fr_[cf][0], Sb[0], a); a = MFMA16(fr_[cf][1], Sb[1], a); oo[cf] = a; } \
_Pragma("unroll") \
            for (int cf = 0; cf < 4; ++cf) \
_Pragma("unroll") \
                for (int s = 0; s < 2; ++s) if (32 * s <= 16 * cf + 15) fr_[cf][s] = DN_FRAG(ATl, 16 * cf + fr, s); \
_Pragma("unroll") \
            for (int cf = 0; cf < 4; ++cf) \
_Pragma("unroll") \
                for (int jj = 0; jj < 4; ++jj) vn[cf][jj] = uu[cf][jj] - vn[cf][jj]; \
_Pragma("unroll") \
            for (int s = 0; s < 2; ++s) { u32x4v w; w.x = pk2(vn[2 * s][0], vn[2 * s][1]); w.y = pk2(vn[2 * s][2], vn[2 * s][3]); w.z = pk2(vn[2 * s + 1][0], vn[2 * s + 1][1]); w.w = pk2(vn[2 * s + 1][2], vn[2 * s + 1][3]); Vb[s] = __builtin_bit_cast(bf16x8, w); } \
_Pragma("unroll") \
            for (int cf = 0; cf < 4; ++cf) \
_Pragma("unroll") \
                for (int s = 0; s < 2; ++s) if (32 * s <= 16 * cf + 15) oo[cf] = MFMA16(fr_[cf][s], Vb[s], oo[cf]); \
_Pragma("unroll") \
            for (int cf = 0; cf < 4; ++cf) \
_Pragma("unroll") \
                for (int s = 0; s < 2; ++s) fr_[cf][s] = DN_FRAG(KDl, 16 * cf + fr, s); \
_Pragma("unroll") \
            for (int df = 0; df < 4; ++df) { f32x4 a = Sacc[df] * egl; a = MFMA16(fr_[df][0], Vb[0], a); a = MFMA16(fr_[df][1], Vb[1], a); Sacc[df] = a; } \
_Pragma("unroll") \
            for (int cf = 0; cf < 4; ++cf) \
_Pragma("unroll") \
                for (int jj = 0; jj < 4; ++jj) OSc[(16 * cf + 4 * q + jj) * 64 + 16 * ef + fr] = oo[cf][jj]; \
        } else if (c > 0) { DN_OUT(c - 1, cz0, cz1); } \
        __syncthreads(); \
    } while (0)
    DN_LOAD(0, A); DN_LOAD(1, B);
    float egl_n = EGL[(size_t)(b * 32) * 4 + hd];
    __syncthreads();
    for (int c2 = 0; c2 < 32; c2 += 2) { DN_BODY(c2, A); DN_BODY(c2 + 1, B); }
    if (wave >= 4) { DN_OUT(31, pz0, pz1); }
    __syncthreads();
#undef DN_LOAD
#undef DN_BODY
#undef DN_OUT
#undef DN_FRAG
}
__device__ __forceinline__ void lru_carry_item(int b, unsigned char* ws, int tid) {
    asm volatile("" : "+v"(tid));
    if (tid < 256) {
        const float2* AGG = (const float2*)(ws + WS_R2 + R2_AGG) + (size_t)b * 64 * 256 + tid;
        float* CARRY = (float*)(ws + WS_R2 + R2_CARRY) + (size_t)b * 64 * 256 + tid;
        float carry = 0.f;
#pragma unroll
        for (int h = 0; h < 2; ++h) {
            float2 ag[32];
#pragma unroll
            for (int k = 0; k < 32; ++k) ag[k] = AGG[(h * 32 + k) * 256];
#pragma unroll
            for (int k = 0; k < 32; ++k) { CARRY[(h * 32 + k) * 256] = carry; carry = ag[k].x * carry + ag[k].y; }
        }
    }
}
__device__ __forceinline__ void lru_fix_item(int item, unsigned char* ws, bf16_t* ybuf, int tid) {
    asm volatile("" : "+v"(tid));
    const int b = item >> 6, c = item & 63, cv = (tid & 31) * 8;
    const float* cp = (const float*)(ws + WS_R2 + R2_CARRY) + (size_t)(b * 64 + c) * 256 + cv;
    const f32x4 ca = *(const f32x4*)cp, cb = *(const f32x4*)(cp + 4);
    u32x4v lh[2], pc[2], gt_[2];
#pragma unroll
    for (int j = 0; j < 2; ++j) { const size_t gt = (size_t)b * SEQ + c * 32 + (tid >> 5) + 16 * j;
        lh[j] = *(const u32x4v*)((const bf16_t*)(ws + WS_R2 + R2_LH) + gt * 256 + cv); pc[j] = *(const u32x4v*)((const bf16_t*)(ws + WS_R2 + R2_PC) + gt * 256 + cv);
        gt_[j] = *(const u32x4v*)((const bf16_t*)(ws + WS_R1) + gt * NIN + U_LRUG + cv); }
#pragma unroll
    for (int j = 0; j < 2; ++j) { const size_t gt = (size_t)b * SEQ + c * 32 + (tid >> 5) + 16 * j;
        u32x4v o;
        o.x = pk2(gelu_tanh(bflo(gt_[j].x)) * (bflo(lh[j].x) + bflo(pc[j].x) * ca[0]), gelu_tanh(bfhi(gt_[j].x)) * (bfhi(lh[j].x) + bfhi(pc[j].x) * ca[1]));
        o.y = pk2(gelu_tanh(bflo(gt_[j].y)) * (bflo(lh[j].y) + bflo(pc[j].y) * ca[2]), gelu_tanh(bfhi(gt_[j].y)) * (bfhi(lh[j].y) + bfhi(pc[j].y) * ca[3]));
        o.z = pk2(gelu_tanh(bflo(gt_[j].z)) * (bflo(lh[j].z) + bflo(pc[j].z) * cb[0]), gelu_tanh(bfhi(gt_[j].z)) * (bfhi(lh[j].z) + bfhi(pc[j].z) * cb[1]));
        o.w = pk2(gelu_tanh(bflo(gt_[j].w)) * (bflo(lh[j].w) + bflo(pc[j].w) * cb[2]), gelu_tanh(bfhi(gt_[j].w)) * (bfhi(lh[j].w) + bfhi(pc[j].w) * cb[3]));
        *(u32x4v*)(ybuf + gt * D + cv) = o; }
}
constexpr int ATT_BT_OFF = 102400;
constexpr int ATT_CT_OFF = 73728;
__device__ __forceinline__ void attn_item(int item, const float* const* in, int l, unsigned char* ws, bf16_t* ybuf, LAS unsigned char* lds, int tid, int lane, int wave) {
    asm volatile("" : "+v"(tid)); lane = tid & 63; wave = __builtin_amdgcn_readfirstlane(tid >> 6);
    const int kh = item & 1, nb = (item >> 1) & 15, b = item >> 5;
    LAS bf16_t* KL = (LAS bf16_t*)lds;
    LAS bf16_t* VT = (LAS bf16_t*)(lds + 36864);
    const LAS float* BT = (const LAS float*)(lds + ATT_BT_OFF);
    LAS float* CT = (LAS float*)(lds + ATT_CT_OFF);
    const bf16_t* U = (const bf16_t*)(ws + WS_R1);
    bf16_t* Y = ybuf;
    const int hl = wave >> 1, hq = kh * 4 + hl, qhalf = wave & 1, fr = lane & 15, q = lane >> 4;
    bf16x8 Bq[4][2];
#pragma unroll
    for (int qg = 0; qg < 4; ++qg) { const bf16_t* qp = U + ((size_t)b * SEQ + nb * 128 + qhalf * 64 + qg * 16 + fr) * NIN + U_AQ + hq * 64 + 8 * q; Bq[qg][0] = *(const bf16x8*)qp; Bq[qg][1] = *(const bf16x8*)(qp + 32); }
    __syncthreads();
#pragma unroll
    for (int i = 0; i < 4; ++i) { const int key = tid & 255, part = (tid >> 8) + 2 * i, pos = (nb - 1) * 128 + key;
        u32x4v kv = (u32x4v){0u, 0u, 0u, 0u}, vv = (u32x4v){0u, 0u, 0u, 0u};
        if (pos >= 0) { const bf16_t* src = U + ((size_t)b * SEQ + pos) * NIN; kv = *(const u32x4v*)(src + 1024 + kh * 64 + part * 8); vv = *(const u32x4v*)(src + 1152 + kh * 64 + part * 8); }
        *(LAS u32x4v*)(KL + key * 72 + part * 8) = kv;
        LAS bf16_t* vd = VT + (part * 8) * 272 + key;
        vd[0] = (bf16_t)(vv.x & 0xffffu); vd[272] = (bf16_t)(vv.x >> 16); vd[2 * 272] = (bf16_t)(vv.y & 0xffffu); vd[3 * 272] = (bf16_t)(vv.y >> 16);
        vd[4 * 272] = (bf16_t)(vv.z & 0xffffu); vd[5 * 272] = (bf16_t)(vv.z >> 16); vd[6 * 272] = (bf16_t)(vv.w & 0xffffu); vd[7 * 272] = (bf16_t)(vv.w >> 16); }
    const float NEG_INF = -__builtin_inff();
    for (int e = tid; e < 4 * 4 * 384; e += NTHR) { const int h = e / 1536, r = e % 1536, sft = r / 384, x = (r % 384) - 128 + sft;
        CT[e] = (x >= 0 && x <= 127) ? BT[(kh * 4 + h) * 128 + (127 - x)] : NEG_INF; }
    __syncthreads();
    const float sink = in[15][l * 8 + hq];
#pragma unroll
    for (int qg = 0; qg < 4; ++qg) {
        const int i0 = qhalf * 64 + qg * 16, iq = i0 + fr, s_lo = 2 * qhalf + (qg >> 1);
        const size_t gt = (size_t)b * SEQ + nb * 128 + iq;
        const bf16x8 Bq0 = Bq[qg][0], Bq1 = Bq[qg][1];
        f32x4 acc[10];
#pragma unroll
        for (int r = 0; r < 10; ++r) { const LAS bf16_t* kp = KL + (16 * (2 * s_lo + r) + fr) * 72 + 8 * q;
            f32x4 a = (f32x4){0.f, 0.f, 0.f, 0.f}; a = MFMA16(*(const LAS bf16x8*)kp, Bq0, a); a = MFMA16(*(const LAS bf16x8*)(kp + 32), Bq1, a); acc[r] = a; }
        const int a1 = iq + 1, sft = (4 - (a1 & 3)) & 3, a4 = (a1 + sft) >> 2;
        const LAS float* ct = CT + (hl * 4 + sft) * 384 + 128 + 4 * (4 * (2 * s_lo) + q - a4);
        float mx = sink;
#pragma unroll
        for (int r = 0; r < 10; ++r) { const f32x4 tb = *(const LAS f32x4*)(ct + 16 * r); const bool dead = (nb == 0) && (2 * s_lo + r < 8);
#pragma unroll
            for (int jj = 0; jj < 4; ++jj) { float sc = acc[r][jj] * 0.125f + tb[jj]; sc = dead ? NEG_INF : sc; acc[r][jj] = sc; mx = fmaxf(mx, sc); } }
        mx = fmaxf(mx, __shfl_xor(mx, 16)); mx = fmaxf(mx, __shfl_xor(mx, 32));
        float sum = 0.f;
#pragma unroll
        for (int r = 0; r < 10; ++r)
#pragma unroll
            for (int jj = 0; jj < 4; ++jj) { const float ev = __expf(acc[r][jj] - mx); acc[r][jj] = ev; sum += ev; }
        sum += __shfl_xor(sum, 16); sum += __shfl_xor(sum, 32);
        const float inv = 1.0f / (sum + __expf(sink - mx));
        f32x4 o[4];
#pragma unroll
        for (int df = 0; df < 4; ++df) o[df] = (f32x4){0.f, 0.f, 0.f, 0.f};
#pragma unroll
        for (int s = 0; s < 5; ++s) {
            u32x4v pw; pw.x = pk2(acc[2 * s][0], acc[2 * s][1]); pw.y = pk2(acc[2 * s][2], acc[2 * s][3]); pw.z = pk2(acc[2 * s + 1][0], acc[2 * s + 1][1]); pw.w = pk2(acc[2 * s + 1][2], acc[2 * s + 1][3]);
            const bf16x8 P = __builtin_bit_cast(bf16x8, pw);
#pragma unroll
            for (int df = 0; df < 4; ++df) { const LAS bf16_t* vp = VT + (16 * df + fr) * 272 + 32 * (s_lo + s) + 4 * q;
                const u32x2v lo = *(const LAS u32x2v*)vp, hi = *(const LAS u32x2v*)(vp + 16);
                u32x4v aw; aw.x = lo.x; aw.y = lo.y; aw.z = hi.x; aw.w = hi.y;
                o[df] = MFMA16(__builtin_bit_cast(bf16x8, aw), P, o[df]); }
        }
#pragma unroll
        for (int df = 0; df < 4; ++df) { u32x2v w; w.x = pk2(o[df][0] * inv, o[df][1] * inv); w.y = pk2(o[df][2] * inv, o[df][3] * inv);
            *(u32x2v*)(Y + gt * D + 256 + hq * 64 + 16 * df + 4 * q) = w; }
    }
}
__device__ __forceinline__ void attn_bias_table(const float* rel_bias, LAS unsigned char* lds, int tid) {
    LAS float* BT = (LAS float*)(lds + ATT_BT_OFF);
    for (int idx = tid; idx < 1024; idx += NTHR) { const int h = idx >> 7, dist = idx & 127;
        int bucket = dist;
        if (dist >= 16) bucket = 16 + (dist >= 19) + (dist >= 21) + (dist >= 24) + (dist >= 27) + (dist >= 31) + (dist >= 35) + (dist >= 40) + (dist >= 46) + (dist >= 52) + (dist >= 59) + (dist >= 67) + (dist >= 77) + (dist >= 87) + (dist >= 99) + (dist >= 113);
        BT[idx] = rel_bias[bucket * 8 + h]; }
}

constexpr int LDS_CTL_OFF = 147456 - 256;
#ifndef PROBE_PRE
#define PROBE_PRE 1
#endif
#ifndef PROBE_PREP
#define PROBE_PREP 1
#endif
#ifndef PROBE_P0
#define PROBE_P0 1
#endif
#ifndef PROBE_G1
#define PROBE_G1 1
#endif
#ifndef ATT_IN_PREP
#define ATT_IN_PREP 512
#endif
#ifndef GEMM_SP2
#define GEMM_SP2 true
#endif
#ifndef PROBE_G2
#define PROBE_G2 1
#endif
#ifndef REV_DOWN
#define REV_DOWN 0
#endif
#ifndef PROBE_G3
#define PROBE_G3 1
#endif
#ifndef CONV_LATE
#define CONV_LATE 0
#endif
#ifndef PROBE_LRUFIX
#define PROBE_LRUFIX 1
#endif
#ifndef PROBE_MAIN
#define PROBE_MAIN 1
#endif
#ifndef PROBE_SYNC
#define PROBE_SYNC 0
#endif
struct Args { const float* in[30]; float* out; unsigned char* ws; };
template <class Epi>
__device__ __forceinline__ void run_gemm(LAS unsigned char* lds, const bf16_t* A, const bf16_t* Bt, int N, int K, const Epi& E, int rev = 0, int gsz = 0, int grank = 0) {
    asm volatile("" : "+s"(K), "+s"(N));
    pg8::Gemm g{A, Bt, T, N, K}; pg8::StaticOrder S; S.init(T, N, gsz > 0 ? gsz : (int)gridDim.x, gsz > 0 ? grank : (int)blockIdx.x, rev);
    pg8::gemm_phase<Epi, pg8::StaticOrder, true, GEMM_SP2>(lds, g, S, E);
}
__global__ void __launch_bounds__(NTHR, 2) hymba_fwd(Args args) {
    extern __shared__ __attribute__((aligned(16))) unsigned char lds_raw[];
    LAS unsigned char* lds = (LAS unsigned char*)lds_raw;
    cg::grid_group grid = cg::this_grid();
    const int tid = threadIdx.x, lane = tid & 63, wave = __builtin_amdgcn_readfirstlane(tid >> 6);
    const int G = gridDim.x, bid = blockIdx.x;
    const int gw = bid * NWAVES + wave, ngw = G * NWAVES;
    const int vcu = (G % 8 == 0) ? (bid % 8) * (G / 8) + bid / 8 : bid;
    const float* const* in = args.in;
    unsigned char* ws = args.ws;
    float* out = args.out;
    bf16_t* R1 = (bf16_t*)(ws + WS_R1);
    bf16_t* PBF = (bf16_t*)(ws + WS_R2 + R2_PBF);
    bf16_t* PBUF = (bf16_t*)(ws + WS_R2 + R2_PBUF);
    float* DNBA = (float*)(ws + WS_R2 + R2_DNBA);

    bf16_t* XA = (bf16_t*)(ws + WS_XN);
    bf16_t* YB = (bf16_t*)out;
    bf16_t* XB = (bf16_t*)(ws + WS_R2 + R2_XB);
    float* RSS = (float*)(ws + WS_RSS);
    if (bid == 0) for (int i = tid; i < XCD_BAR_WORDS; i += NTHR) ((unsigned*)ws)[i] = 0u;
    if (tid < 2) ((LAS unsigned*)(lds + LDS_CTL_OFF))[tid] = 0u;
    for (int rep = 0; rep < PROBE_P0; ++rep) {
    convert_weights(in, ws, (LAS float*)(lds + wave * 16384), gw, ngw, lane, 0, NL * CONV_PER_LAYER - CONV_LATE);
    rows_bf16_sumsq(in[0], XA, RSS, gw, ngw, lane);
    }
    grid.sync();
    const XcdBarrier xbar = xcd_barrier_post((unsigned*)ws, (volatile LAS unsigned*)(lds + LDS_CTL_OFF));
#define GSYNC() xcd_barrier(xbar)

    for (int l = 0; l < NL; ++l) {
        const unsigned char* wl = ws + WS_W + (size_t)l * W_LAYER;
        int tid = threadIdx.x; asm volatile("" : "+v"(tid)); int lane = tid & 63;
        const bf16_t* hin = (l == 0) ? XA : XB;
        float* rss0 = RSS, *rss1 = RSS + (size_t)4 * T, *rss2 = RSS, *rss3 = RSS + (size_t)4 * T, *rss4 = RSS;
        LAS float* part = (LAS float*)(lds + EPI_LDS_OFF);
        for (int rep = 0; rep < PROBE_G1; ++rep) {
        { EpiSwiglu E{R1, rss0}; run_gemm(lds, l == 0 ? XA : XB, (const bf16_t*)(wl + O_GU1), 2 * FF, D, E); }
        GSYNC();
        }
        for (int rep = 1; rep < (l == 0 ? PROBE_G2 : 1); ++rep) {
        { EpiResid E{hin, XB, 0.5f, rss1, part}; run_gemm(lds, R1, (const bf16_t*)(wl + O_D1), D, FF, E, REV_DOWN); }
        GSYNC();
        }
        { EpiResid E{hin, XA, 0.5f, rss1, part}; run_gemm(lds, R1, (const bf16_t*)(wl + O_D1), D, FF, E, REV_DOWN); }
        GSYNC();
        for (int rep = 0; rep < PROBE_G3; ++rep) {
        { EpiBf16<NIN, true> E{R1, DNBA, rss1}; run_gemm(lds, XA, (const bf16_t*)(wl + O_IN), NIN, D, E); }
        GSYNC();
        }
        for (int rep = 0; rep < PROBE_PRE; ++rep) {
        for (int it = vcu; it < NBATCH * 64; it += G) mixer_pre_item(it, in, l, ws, lds, tid, lane, wave);
        { int t_ = threadIdx.x; asm volatile("" : "+v"(t_)); convert_p(in[1] + (size_t)l * T * PLE, PBF, (size_t)bid * NTHR + t_, (size_t)G * NTHR); }
        GSYNC();
        }
        for (int rep = 0; rep < PROBE_PREP; ++rep) {
            attn_bias_table(in[16], lds, tid);
            for (int b2 = G - 1 - bid; b2 < NBATCH; b2 += G) lru_carry_item(b2, ws, tid);
            for (int it = vcu; it < NBATCH * 32; it += G) dn_prep_item(it, ws, lds, tid, lane, wave);
            for (int it = vcu; it < ATT_IN_PREP; it += G) attn_item(511 - it, in, l, ws, YB, lds, tid, lane, wave);
            GSYNC();
        }
        for (int rep = 0; rep < PROBE_MAIN; ++rep) {
            if (ATT_IN_PREP < 512) { attn_bias_table(in[16], lds, tid); __syncthreads(); }
            if (G >= 128) {
                if (bid < 64) dn_chain_item(bid, in, l, ws, YB, lds, tid, lane, wave);
                else { const int r = bid - 64, R = G - 64;
                    for (int it = r; it < 512 - ATT_IN_PREP; it += R) attn_item(it, in, l, ws, YB, lds, tid, lane, wave);
                    for (int rep2 = 0; rep2 < PROBE_LRUFIX; ++rep2)
                    for (int it = r; it < NBATCH * 64; it += R) lru_fix_item(it, ws, YB, tid);
                    { __syncthreads(); EpiBf16<D, false> E{PBUF, nullptr, nullptr}; run_gemm(lds, PBF, (const bf16_t*)(wl + O_PP), D, PLE, E, 0, R, r); }
                    if (l == 0 && CONV_LATE > 0) { __syncthreads(); convert_weights(in, ws, (LAS float*)(lds + wave * 16384), r * NWAVES + wave, R * NWAVES, lane, NL * CONV_PER_LAYER - CONV_LATE, NL * CONV_PER_LAYER); }
                }
            } else {
                for (int it = bid; it < 64; it += G) dn_chain_item(it, in, l, ws, YB, lds, tid, lane, wave);
                attn_bias_table(in[16], lds, tid);
                for (int it = bid; it < 512 - ATT_IN_PREP; it += G) attn_item(it, in, l, ws, YB, lds, tid, lane, wave);
                for (int it = bid; it < NBATCH * 64; it += G) lru_fix_item(it, ws, YB, tid);
                { __syncthreads(); EpiBf16<D, false> E{PBUF, nullptr, nullptr}; run_gemm(lds, PBF, (const bf16_t*)(wl + O_PP), D, PLE, E); }
                if (l == 0 && CONV_LATE > 0) { __syncthreads(); convert_weights(in, ws, (LAS float*)(lds + wave * 16384), gw, ngw, lane, NL * CONV_PER_LAYER - CONV_LATE, NL * CONV_PER_LAYER); }
            }
            GSYNC();
        }
        { EpiResid E{XA, XA, 1.0f, rss2, part}; run_gemm(lds, YB, (const bf16_t*)(wl + O_OUT), D, D, E); }
        GSYNC();
        { EpiSwiglu E{R1, rss2}; run_gemm(lds, XA, (const bf16_t*)(wl + O_GU2), 2 * FF, D, E); }
        GSYNC();
        { EpiResid E{XA, XA, 0.5f, rss3, part}; run_gemm(lds, R1, (const bf16_t*)(wl + O_D2), D, FF, E, REV_DOWN); }
        GSYNC();
        { EpiPle E{XA, XB, PBUF, rss3, rss4, part}; run_gemm(lds, XA, (const bf16_t*)(wl + O_PG), D, D, E); }
        GSYNC();
    }
    final_norm_rows(XB, in[29], out, gw, ngw, lane);
}

extern "C" void kernel_launch(void* const* d_in, const int* in_sizes, int n_in, void* d_out, int out_size, void* d_ws, size_t ws_size, hipStream_t stream) {
    static int grid = 0;
    if (grid == 0) {
        if (n_in != 30 || out_size != T * D || ws_size < WS_END) { fprintf(stderr, "kernel_launch: unexpected shapes n_in %d out %d ws %zu (need %zu)\n", n_in, out_size, ws_size, (size_t)WS_END); grid = -1; return; }
        int dev = 0, cus = 0, per_cu = 0;
        (void)hipGetDevice(&dev);
        (void)hipDeviceGetAttribute(&cus, hipDeviceAttributeMultiprocessorCount, dev);
        (void)hipFuncSetAttribute((const void*)hymba_fwd, hipFuncAttributeMaxDynamicSharedMemorySize, LDS_BYTES);
        (void)hipOccupancyMaxActiveBlocksPerMultiprocessor(&per_cu, (const void*)hymba_fwd, NTHR, LDS_BYTES);
        if (per_cu < 1) per_cu = 1;
        (void)hipGetLastError();
        grid = cus * per_cu;
        fprintf(stderr, "kernel_launch: grid %d (cus %d x %d)\n", grid, cus, per_cu);
    }
    if (grid < 0) return;
    Args a{};
    for (int i = 0; i < 30; ++i) a.in[i] = (const float*)d_in[i];
    a.out = (float*)d_out; a.ws = (unsigned char*)d_ws;
    void* kargs[] = {&a};
    hipError_t e = hipLaunchCooperativeKernel((void*)hymba_fwd, dim3(grid), dim3(NTHR), kargs, LDS_BYTES, stream);
    if (e != hipSuccess) fprintf(stderr, "kernel_launch: cooperative launch failed: %s (grid %d)\n", hipGetErrorString(e), grid);
}
```
